# Optimizing an MI355X kernel written in HIP

```python
import jax
import jax.numpy as jnp
from jax import lax
import numpy as np

D_MODEL = 2048
BATCH = 4
SEQ = 4096
DEPTH = 2

CTX_LEN = 256
GRID_W = 64
EPS = 1e-6
NEG = -1e30
N_MOD = 3
A_HEADS = 4
A_DK = 128
A_DV = 128
A_WIDTH = A_HEADS * A_DV
B_HEADS = 4
B_DH = 128
B_WIDTH = B_HEADS * B_DH
C_Q_HEADS = 8
C_KV_HEADS = 2
C_DH = 128
C_WIDTH = C_Q_HEADS * C_DH
MIX_WIDTH = A_WIDTH + B_WIDTH + C_WIDTH
CHUNK = 64
CONV_WIDTH = 3
ATTN_BLOCK = 128
WINDOW = 128
ROPE_BASE = 10000.0
ROPE_AXIS_DIM = C_DH // 2
PROJ_LAYOUT = (
    ('a_q', A_HEADS * A_DK), ('a_f_fwd', A_HEADS * A_DK), ('a_f_bwd', A_HEADS * A_DK),
    ('a_i', A_WIDTH), ('a_gate', A_WIDTH),
    ('b_q', B_WIDTH), ('b_k', B_WIDTH), ('b_v', B_WIDTH), ('b_o', B_WIDTH),
    ('b_gates', 4 * B_HEADS), ('b_z', B_WIDTH),
    ('c_q', C_WIDTH), ('c_k', C_KV_HEADS * C_DH), ('c_v', C_KV_HEADS * C_DH), ('c_z', C_WIDTH),
)
PROJ_WIDTH = 3 * A_HEADS * A_DK + 2 * A_WIDTH + 5 * B_WIDTH + 4 * B_HEADS + 2 * C_WIDTH + 2 * C_KV_HEADS * C_DH

kernel_name = 'hybrid_hgrn2_mlstm_swa_prefix_block'


def rms_norm(h, gain=None):
    h32 = h.astype(jnp.float32)
    y = h32 * lax.rsqrt(jnp.mean(h32 * h32, axis=-1, keepdims=True) + EPS)
    if gain is not None:
        y = y * gain.astype(jnp.float32)
    return y.astype(h.dtype)


def modulate(h, gain, shift, scale):
    return rms_norm(h, gain) * (1.0 + scale) + shift


def split_proj(p):
    parts, start = {}, 0
    for name, width in PROJ_LAYOUT:
        parts[name] = p[..., start:start + width]
        start += width
    return parts


def to_heads(a, n_heads):
    return a.reshape(a.shape[:-1] + (n_heads, a.shape[-1] // n_heads))


def join_dir(a_ctx, a_lat, reverse):
    if reverse:
        a_ctx, a_lat = a_ctx[:, ::-1], a_lat[:, ::-1]
    return jnp.concatenate([a_ctx, a_lat], axis=1)


def split_dir(y, n_ctx, reverse):
    y_ctx, y_lat = y[:, :n_ctx], y[:, n_ctx:]
    if reverse:
        y_ctx, y_lat = y_ctx[:, ::-1], y_lat[:, ::-1]
    return y_ctx, y_lat


def to_chunks(a):
    b, t = a.shape[:2]
    a = a.reshape((b, t // CHUNK, CHUNK) + a.shape[2:])
    return jnp.moveaxis(a, (1, 3), (0, 2))


def from_chunks(o):
    o = jnp.moveaxis(o, (0, 2), (1, 3))
    return o.reshape((o.shape[0], o.shape[1] * o.shape[2]) + o.shape[3:])


def hgrn2_scan(q, k, v, log_f):
    b, _, h, dk = q.shape
    dv = v.shape[-1]
    causal = jnp.tril(jnp.ones((CHUNK, CHUNK), bool))

    def step(state, inp):
        qc, kc, vc, fc = inp
        cum = jnp.cumsum(fc, axis=2)
        diff = cum[:, :, :, None, :] - cum[:, :, None, :, :]
        decay = jnp.exp(jnp.where(causal[:, :, None], diff, NEG))
        scores = jnp.einsum('bhtd,bhtsd,bhsd->bhts', qc, decay, kc)
        out = (jnp.einsum('bhtd,bhdv->bhtv', qc * jnp.exp(cum), state)
               + jnp.einsum('bhts,bhsv->bhtv', scores, vc))
        cum_end = cum[:, :, -1]
        state = (jnp.exp(cum_end)[..., None] * state
                 + jnp.einsum('bhsd,bhsv->bhdv', kc * jnp.exp(cum_end[:, :, None] - cum), vc))
        return state, out

    s0 = jnp.zeros((b, h, dk, dv), jnp.float32)
    _, out = lax.scan(step, s0, tuple(to_chunks(a) for a in (q, k, v, log_f)))
    return from_chunks(out)


def mlstm_scan(q, k, v, log_i, log_f):
    b, _, h, dk = q.shape
    dv = v.shape[-1]
    causal = jnp.tril(jnp.ones((CHUNK, CHUNK), bool))

    def step(carry, inp):
        c_mat, n_vec, m = carry
        qc, kc, vc, ic, fc = inp
        cum = jnp.cumsum(fc, axis=-1)
        log_d = jnp.where(causal, cum[..., :, None] - cum[..., None, :] + ic[..., None, :], NEG)
        inter = cum + m[..., None]
        m_t = jnp.maximum(inter, jnp.max(log_d, axis=-1))
        w_intra = jnp.exp(log_d - m_t[..., None])
        w_inter = jnp.exp(inter - m_t)
        s = jnp.einsum('bhtd,bhsd->bhts', qc, kc) * w_intra
        num = (w_inter[..., None] * jnp.einsum('bhtd,bhdv->bhtv', qc, c_mat)
               + jnp.einsum('bhts,bhsv->bhtv', s, vc))
        den = w_inter * jnp.einsum('bhtd,bhd->bht', qc, n_vec) + jnp.sum(s, axis=-1)
        h_out = num / jnp.maximum(jnp.abs(den), jnp.exp(-m_t))[..., None]
        log_w = cum[..., -1:] - cum + ic
        m_new = jnp.maximum(cum[..., -1] + m, jnp.max(log_w, axis=-1))
        w = jnp.exp(log_w - m_new[..., None])
        carry_scale = jnp.exp(cum[..., -1] + m - m_new)
        c_mat = carry_scale[..., None, None] * c_mat + jnp.einsum('bhs,bhsd,bhsv->bhdv', w, kc, vc)
        n_vec = carry_scale[..., None] * n_vec + jnp.einsum('bhs,bhsd->bhd', w, kc)
        return (c_mat, n_vec, m_new), h_out

    init = (jnp.zeros((b, h, dk, dv), jnp.float32), jnp.zeros((b, h, dk), jnp.float32),
            jnp.zeros((b, h), jnp.float32))
    _, out = lax.scan(step, init, tuple(to_chunks(a) for a in (q, k, v, log_i, log_f)))
    return from_chunks(out)


def short_conv(a, w):
    pad = CONV_WIDTH // 2
    t = a.shape[1]
    ap = jnp.pad(a, ((0, 0), (pad, pad), (0, 0)))
    acc = w[0] * ap[:, 0:t]
    for j in range(1, CONV_WIDTH):
        acc = acc + w[j] * ap[:, j:j + t]
    return acc


def rotate_pairs(x, cos, sin):
    x1, x2 = jnp.split(x, 2, axis=-1)
    cos = cos[None, :, None, :]
    sin = sin[None, :, None, :]
    return jnp.concatenate([x1 * cos - x2 * sin, x2 * cos + x1 * sin], axis=-1)


def axial_rope(x, rope):
    cos_r, sin_r, cos_c, sin_c = rope
    x_row, x_col = jnp.split(x.astype(jnp.float32), 2, axis=-1)
    y = jnp.concatenate([rotate_pairs(x_row, cos_r, sin_r), rotate_pairs(x_col, cos_c, sin_c)], axis=-1)
    return y.astype(x.dtype)


def window_attention(q, k, v, k_ctx, v_ctx, sink):
    b, n, hq, dh = q.shape
    hkv = k.shape[2]
    g = hq // hkv
    nb = n // ATTN_BLOCK
    span = 3 * ATTN_BLOCK
    n_ctx = k_ctx.shape[1]
    qb = q.reshape(b, nb, ATTN_BLOCK, hkv, g, dh)

    def band_windows(a):
        ap = jnp.pad(a.reshape(b, nb, ATTN_BLOCK, hkv, dh), ((0, 0), (1, 1), (0, 0), (0, 0), (0, 0)))
        return jnp.concatenate([ap[:, :-2], ap[:, 1:-1], ap[:, 2:]], axis=2)

    kw, vw = band_windows(k), band_windows(v)
    qi = jnp.arange(ATTN_BLOCK)
    kj = jnp.arange(span)
    blk = jnp.arange(nb)
    band = jnp.abs(kj[None, :] - qi[:, None] - ATTN_BLOCK) <= WINDOW
    kpos = (blk[:, None] - 1) * ATTN_BLOCK + kj[None, :]
    mask = band[None] & ((kpos >= 0) & (kpos < n))[:, None, :]
    scale = dh ** -0.5
    s_loc = jnp.einsum('bnqkgd,bnskd->bnkgqs', qb, kw, preferred_element_type=jnp.float32) * scale
    s_loc = jnp.where(mask[None, :, None, None], s_loc, NEG)
    s_ctx = jnp.einsum('bnqkgd,bckd->bnkgqc', qb, k_ctx, preferred_element_type=jnp.float32) * scale
    s_sink = jnp.broadcast_to(sink.astype(jnp.float32).reshape(1, 1, hkv, g, 1, 1), s_loc.shape[:-1] + (1,))
    p = jax.nn.softmax(jnp.concatenate([s_loc, s_ctx, s_sink], axis=-1), axis=-1).astype(v.dtype)
    out = (jnp.einsum('bnkgqs,bnskd->bnqkgd', p[..., :span], vw)
           + jnp.einsum('bnkgqc,bckd->bnqkgd', p[..., span:span + n_ctx], v_ctx))
    return out.reshape(b, n, hq * dh)


def context_attention(q, k, v, sink):
    b, n_ctx, hq, dh = q.shape
    hkv = k.shape[2]
    g = hq // hkv
    qg = q.reshape(b, n_ctx, hkv, g, dh)
    s = jnp.einsum('bqkgd,bskd->bkgqs', qg, k, preferred_element_type=jnp.float32) * dh ** -0.5
    s_sink = jnp.broadcast_to(sink.astype(jnp.float32).reshape(1, hkv, g, 1, 1), s.shape[:-1] + (1,))
    p = jax.nn.softmax(jnp.concatenate([s, s_sink], axis=-1), axis=-1).astype(v.dtype)
    out = jnp.einsum('bkgqs,bskd->bqkgd', p[..., :n_ctx], v)
    return out.reshape(b, n_ctx, hq * dh)


def hgrn2_branch(pc, pl, lower_bound, with_ctx):
    n_ctx = pc['a_q'].shape[1]
    ys_ctx, ys_lat = [], []
    for d, (f_name, reverse) in enumerate((('a_f_fwd', False), ('a_f_bwd', True))):
        q = to_heads(jax.nn.silu(join_dir(pc['a_q'], pl['a_q'], reverse).astype(jnp.float32)), A_HEADS)
        zf = to_heads(join_dir(pc[f_name], pl[f_name], reverse).astype(jnp.float32), A_HEADS)
        i_in = to_heads(join_dir(pc['a_i'], pl['a_i'], reverse).astype(jnp.float32), A_HEADS)
        lb = lower_bound[d]
        log_f = jnp.log(lb + (1.0 - lb) * jax.nn.sigmoid(zf))
        k = (1.0 - lb) * jax.nn.sigmoid(-zf)
        y_ctx, y_lat = split_dir(hgrn2_scan(q, k, i_in, log_f), n_ctx, reverse)
        ys_ctx.append(y_ctx)
        ys_lat.append(y_lat)

    def readout(y, gate):
        y = rms_norm(y).reshape(y.shape[:2] + (A_WIDTH,))
        return (y * jax.nn.silu(gate.astype(jnp.float32))).astype(gate.dtype)

    lat = readout(ys_lat[0] + ys_lat[1], pl['a_gate'])
    ctx = readout(ys_ctx[0] + ys_ctx[1], pc['a_gate']) if with_ctx else None
    return ctx, lat


def mlstm_branch(pc, pl, conv_w, gate_bias, with_ctx):
    n_ctx = pc['b_q'].shape[1]

    def qk_path(p):
        a = jax.nn.silu(short_conv(jnp.concatenate([p['b_q'], p['b_k']], axis=-1), conv_w))
        return a[..., :B_WIDTH], a[..., B_WIDTH:]

    q_c, k_c = qk_path(pc)
    q_l, k_l = qk_path(pl)
    g_c = pc['b_gates'] + gate_bias
    g_l = pl['b_gates'] + gate_bias
    ys_ctx, ys_lat = [], []
    for d, reverse in enumerate((False, True)):
        i_sl = slice((2 * d) * B_HEADS, (2 * d + 1) * B_HEADS)
        f_sl = slice((2 * d + 1) * B_HEADS, (2 * d + 2) * B_HEADS)
        q = to_heads(join_dir(q_c, q_l, reverse).astype(jnp.float32), B_HEADS) * (B_DH ** -0.5)
        k = to_heads(join_dir(k_c, k_l, reverse).astype(jnp.float32), B_HEADS)
        v = to_heads(join_dir(pc['b_v'], pl['b_v'], reverse).astype(jnp.float32), B_HEADS)
        log_i = join_dir(g_c[..., i_sl], g_l[..., i_sl], reverse).astype(jnp.float32)
        log_f = jax.nn.log_sigmoid(join_dir(g_c[..., f_sl], g_l[..., f_sl], reverse).astype(jnp.float32))
        y_ctx, y_lat = split_dir(mlstm_scan(q, k, v, log_i, log_f), n_ctx, reverse)
        ys_ctx.append(y_ctx)
        ys_lat.append(y_lat)

    def readout(y, p):
        h = jax.nn.sigmoid(to_heads(p['b_o'], B_HEADS).astype(jnp.float32)) * y
        h = rms_norm(h).reshape(h.shape[:2] + (B_WIDTH,))
        return (h * jax.nn.silu(p['b_z'].astype(jnp.float32))).astype(p['b_z'].dtype)

    lat = readout(ys_lat[0] + ys_lat[1], pl)
    ctx = readout(ys_ctx[0] + ys_ctx[1], pc) if with_ctx else None
    return ctx, lat


def attention_branch(pc, pl, sink, rope, with_ctx):
    q = axial_rope(to_heads(pl['c_q'], C_Q_HEADS), rope)
    k = axial_rope(to_heads(pl['c_k'], C_KV_HEADS), rope)
    v = to_heads(pl['c_v'], C_KV_HEADS)
    k_ctx = to_heads(pc['c_k'], C_KV_HEADS)
    v_ctx = to_heads(pc['c_v'], C_KV_HEADS)
    lat = window_attention(q, k, v, k_ctx, v_ctx, sink) * jax.nn.silu(pl['c_z'])
    ctx = None
    if with_ctx:
        ctx = context_attention(to_heads(pc['c_q'], C_Q_HEADS), k_ctx, v_ctx, sink) * jax.nn.silu(pc['c_z'])
    return ctx, lat


def setup_inputs(seed: int = 0) -> dict:
    key = jax.random.key(seed)
    ks = jax.random.split(key, 16)
    nrm = jax.random.normal
    x = nrm(ks[0], (BATCH, SEQ, D_MODEL), jnp.float32)
    c = nrm(ks[1], (BATCH, D_MODEL), jnp.float32)
    ctx = nrm(ks[2], (BATCH, CTX_LEN, D_MODEL), jnp.float32)
    c_ctx = nrm(ks[3], (D_MODEL,), jnp.float32)
    w_mod = nrm(ks[4], (DEPTH, D_MODEL, N_MOD * D_MODEL), jnp.float32) * D_MODEL ** -0.5
    b_mod = 0.02 * nrm(ks[5], (DEPTH, N_MOD * D_MODEL), jnp.float32)
    g_pre = 1.0 + 0.05 * nrm(ks[6], (DEPTH, D_MODEL), jnp.float32)
    g_post = 1.0 + 0.05 * nrm(ks[7], (DEPTH, D_MODEL), jnp.float32)
    w_in = nrm(ks[8], (DEPTH, D_MODEL, PROJ_WIDTH), jnp.float32) * D_MODEL ** -0.5
    hgrn_lb_logits = nrm(ks[9], (DEPTH, 2 * A_HEADS * A_DK), jnp.float32)
    mlstm_conv_w = nrm(ks[10], (DEPTH, CONV_WIDTH, 2 * B_WIDTH), jnp.float32) * CONV_WIDTH ** -0.5
    i_bias = 0.1 * nrm(ks[11], (DEPTH, 2, 1, B_HEADS), jnp.float32)
    f_bias = 3.0 + 3.0 * jax.random.uniform(ks[12], (DEPTH, 2, 1, B_HEADS), jnp.float32)
    mlstm_gate_bias = jnp.concatenate([i_bias, f_bias], axis=2).reshape(DEPTH, 4 * B_HEADS)
    attn_sink = nrm(ks[13], (DEPTH, C_Q_HEADS), jnp.float32)
    w_out = nrm(ks[14], (DEPTH, MIX_WIDTH, D_MODEL), jnp.float32) * MIX_WIDTH ** -0.5
    return {'x': x, 'c': c, 'ctx': ctx, 'c_ctx': c_ctx, 'w_mod': w_mod, 'b_mod': b_mod,
            'g_pre': g_pre, 'g_post': g_post, 'w_in': w_in, 'hgrn_lb_logits': hgrn_lb_logits,
            'mlstm_conv_w': mlstm_conv_w, 'mlstm_gate_bias': mlstm_gate_bias,
            'attn_sink': attn_sink, 'w_out': w_out}


def reference(x, c, ctx, c_ctx, w_mod, b_mod, g_pre, g_post, w_in, hgrn_lb_logits,
              mlstm_conv_w, mlstm_gate_bias, attn_sink, w_out):
    n_lat = x.shape[1]
    rows = n_lat // GRID_W
    row = jnp.repeat(jnp.arange(rows, dtype=jnp.float32), GRID_W)
    col = jnp.tile(jnp.arange(GRID_W, dtype=jnp.float32), rows)
    inv_freq = ROPE_BASE ** (-jnp.arange(0, ROPE_AXIS_DIM, 2, dtype=jnp.float32) / ROPE_AXIS_DIM)
    ang_r = row[:, None] * inv_freq[None, :]
    ang_c = col[:, None] * inv_freq[None, :]
    rope = (jnp.cos(ang_r), jnp.sin(ang_r), jnp.cos(ang_c), jnp.sin(ang_c))
    lb_w = jax.nn.softmax(hgrn_lb_logits.astype(jnp.float32), axis=0)
    lower_bounds = jnp.cumsum(lb_w, axis=0) - lb_w[0]
    h_ctx = ctx
    for layer in range(DEPTH):
        with_ctx = layer < DEPTH - 1
        mod_lat = (jax.nn.silu(c) @ w_mod[layer] + b_mod[layer])[:, None, :]
        mod_ctx = (jax.nn.silu(c_ctx) @ w_mod[layer] + b_mod[layer])[None, None, :]
        shift_l, scale_l, gate_l = jnp.split(mod_lat, N_MOD, axis=-1)
        shift_c, scale_c, gate_c = jnp.split(mod_ctx, N_MOD, axis=-1)
        pl = split_proj(modulate(x, g_pre[layer], shift_l, scale_l) @ w_in[layer])
        pc = split_proj(modulate(h_ctx, g_pre[layer], shift_c, scale_c) @ w_in[layer])
        a_c, a_l = hgrn2_branch(pc, pl, lower_bounds[layer].reshape(2, A_HEADS, A_DK), with_ctx)
        b_c, b_l = mlstm_branch(pc, pl, mlstm_conv_w[layer], mlstm_gate_bias[layer], with_ctx)
        c_c, c_l = attention_branch(pc, pl, attn_sink[layer], rope, with_ctx)
        y_lat = jnp.concatenate([a_l, b_l, c_l], axis=-1) @ w_out[layer]
        x = x + gate_l * rms_norm(y_lat, g_post[layer])
        if with_ctx:
            y_ctx = jnp.concatenate([a_c, b_c, c_c], axis=-1) @ w_out[layer]
            h_ctx = h_ctx + gate_c * rms_norm(y_ctx, g_post[layer])
    return x
```

```cpp
#include <hip/hip_runtime.h>
#include <hip/hip_cooperative_groups.h>
#include <cstdio>
#include <cstdint>
#include <type_traits>
namespace cg = cooperative_groups;
__device__ __forceinline__ int opaque_tid() { int t = threadIdx.x; asm volatile("" : "+v"(t)); return t; }
__device__ __forceinline__ int opaque_bid() { int t = blockIdx.x; asm volatile("" : "+s"(t)); return t; }
#define MK_PER_PHASE 0
namespace pg8 {
#define PG8_LAS __attribute__((address_space(3)))
typedef unsigned short bf16_t;
typedef short bf16x8 __attribute__((ext_vector_type(8)));
typedef float f32x4 __attribute__((ext_vector_type(4)));
typedef unsigned u32x4 __attribute__((ext_vector_type(4)));
constexpr int BM = 256, BK = 64, HALF = 128, HTB = HALF * BK * 2  , STAGE_BYTES = 8 * HTB, NXCD = 8, WGM = 8;

__host__ __device__ __forceinline__ int lds_byte(int r, int c) { const int st = (r >> 4) * 2 + (c >> 5), rr = r & 15, cc = c & 31, ob = rr * 64 + cc * 2; return st * 1024 + (ob ^ (((ob >> 9) & 1) << 5)); }
__host__ __device__ __forceinline__ void stage_rc(int b, int& R, int& C) { const int st = b / 1024, sb = b % 1024, swz = sb ^ (((sb >> 9) & 1) << 5); R = (st >> 1) * 16 + swz / 64; C = (st & 1) * 32 + (swz % 64) / 2; }
__host__ __device__ __forceinline__ int perm32(int rho) { const int n = rho >> 4, i = rho & 15; return 8 * (i >> 2) + 4 * n + (i & 3); }

struct Unit { int pm, pn; };
struct Gemm { const bf16_t* A; const bf16_t* Bt; int M, N, K; };

struct StaticOrder {
    int nM, nN, nwg, G, c;
    __host__ __device__ void init(int M, int N, int G_, int c_) { nM = M / BM; nN = N / BM; nwg = nM * nN; G = G_; c = c_; }
    __host__ __device__ bool next(int i, Unit& u) const {
        const long L = (long)i * G + c; if (L >= nwg) return false;
        int wgid = (int)L; { const int q = nwg / NXCD, r = nwg % NXCD, xcd = wgid % NXCD, off = wgid / NXCD; wgid = (xcd < r ? xcd * (q + 1) : r * (q + 1) + (xcd - r) * q) + off; }
        const int nig = WGM * nN, gid = wgid / nig, fm = gid * WGM, gsz = (nM - fm) < WGM ? (nM - fm) : WGM;
        u.pm = fm + ((wgid % nig) % gsz); u.pn = (wgid % nig) / gsz; return true;
    }
    __device__ __forceinline__ void a_ready(const Unit&) const {}
    __device__ __forceinline__ void done(const Unit&) const {}
};

__device__ __forceinline__ unsigned cvt_pk_bf16(float lo, float hi) { unsigned r; asm volatile("v_cvt_pk_bf16_f32 %0, %1, %2" : "=v"(r) : "v"(lo), "v"(hi)); return r; }
typedef float f32x2 __attribute__((ext_vector_type(2)));
template <class Epi, class Sched, bool ALIGN_EPI = false, bool SP2 = false>
__device__ __forceinline__ void gemm_phase(PG8_LAS unsigned char* lds, const Gemm g, const Sched& S, const Epi& E) {
    const int tid = opaque_tid(), wid = __builtin_amdgcn_readfirstlane(tid >> 6), lane = tid & 63, wr = wid >> 2, wc = wid & 3, fr = lane & 15, fq = lane >> 4;
    const int K = g.K, nt = K / BK;
    unsigned voffA[2], voffB[2];
#pragma unroll
    for (int i = 0; i < 2; ++i) { int R, C; stage_rc(tid * 16 + i * 8192, R, C); const int Rb = Epi::PERM ? ((R & ~31) + perm32(R & 31)) : R;
        voffA[i] = (unsigned)(R * K + C) * 2u; voffB[i] = (unsigned)(Rb * K + C) * 2u; }
    const size_t kstep = (size_t)(BK * 2);
    const size_t hstep = (size_t)HALF * K * 2;
    const size_t tstep = 2 * hstep;
    const unsigned ldsw = (unsigned)wid * 1024u;
    const int aoff = lds_byte(wr * 64 + fr, fq * 8), boff = lds_byte(wc * 32 + fr, fq * 8);
#define PG8_SA(b, h) (((b) * 2 + (h)) * HTB)
#define PG8_SB(b, h) ((4 + (b) * 2 + (h)) * HTB)
#define PG8_STAGE(bufoff, gbase, voff) do { _Pragma("unroll") for (int _i = 0; _i < 2; ++_i) \
        __builtin_amdgcn_global_load_lds((const unsigned*)((const char*)(gbase) + (voff)[_i]), (PG8_LAS unsigned*)(lds + (bufoff) + ldsw + _i * 8192), 16, 0, 0); } while (0)
#define PG8_LDA(dst, b, h) do { _Pragma("unroll") for (int m = 0; m < 4; ++m) _Pragma("unroll") for (int k = 0; k < 2; ++k) dst[m][k] = *(const PG8_LAS bf16x8*)(lds + PG8_SA(b, h) + aoff + m * 2048 + k * 1024); } while (0)
#define PG8_LDB(dst, b, h) do { _Pragma("unroll") for (int n = 0; n < 2; ++n) _Pragma("unroll") for (int k = 0; k < 2; ++k) dst[n][k] = *(const PG8_LAS bf16x8*)(lds + PG8_SB(b, h) + boff + n * 2048 + k * 1024); } while (0)
#define PG8_MMA(ai, bj, At, Bt) do { __builtin_amdgcn_s_setprio(1); _Pragma("unroll") for (int m = 0; m < 4; ++m) _Pragma("unroll") for (int n = 0; n < 2; ++n) _Pragma("unroll") for (int k = 0; k < 2; ++k) \
        acc[ai][bj][m][n] = __builtin_amdgcn_mfma_f32_16x16x32_bf16(Bt[n][k], At[m][k], acc[ai][bj][m][n], 0, 0, 0); __builtin_amdgcn_s_setprio(0); } while (0)
#define PG8_WAIT_V(n) asm volatile("s_waitcnt vmcnt(" #n ")" ::: "memory")
#define PG8_WAIT_L(n) asm volatile("s_waitcnt lgkmcnt(" #n ")" ::: "memory")
#define PG8_BAR __builtin_amdgcn_s_barrier()
#define PG8_SCHED __builtin_amdgcn_sched_barrier(0)
    Unit cur, nxt; int ui = 0;
    if (!S.next(0, cur)) return;
    f32x4 acc[2][2][4][2];
#pragma unroll
    for (int a = 0; a < 2; ++a)
#pragma unroll
        for (int b = 0; b < 2; ++b)
#pragma unroll
            for (int m = 0; m < 4; ++m)
#pragma unroll
                for (int n = 0; n < 2; ++n) acc[a][b][m][n] = (f32x4){0.f, 0.f, 0.f, 0.f};
    bf16x8 At[4][2], B0[2][2], B1[2][2];
    const char* cA = (const char*)g.A + (size_t)cur.pm * tstep; const char* cB = (const char*)g.Bt + (size_t)cur.pn * tstep;
    S.a_ready(cur);
    if constexpr (SP2) {
        PG8_STAGE(PG8_SB(0, 0), cB, voffB); PG8_STAGE(PG8_SB(0, 1), cB + hstep, voffB); PG8_STAGE(PG8_SA(0, 0), cA, voffA); PG8_STAGE(PG8_SA(0, 1), cA + hstep, voffA);
        if (wr == 1) PG8_BAR;
        PG8_WAIT_V(2); PG8_BAR;
        PG8_STAGE(PG8_SB(1, 0), cB + kstep, voffB); PG8_STAGE(PG8_SA(1, 0), cA + kstep, voffA); PG8_STAGE(PG8_SB(1, 1), cB + hstep + kstep, voffB);
        PG8_WAIT_V(6); PG8_BAR;
    } else {
        PG8_STAGE(PG8_SB(0, 0), cB, voffB); PG8_STAGE(PG8_SA(0, 0), cA, voffA); PG8_STAGE(PG8_SB(0, 1), cB + hstep, voffB); PG8_STAGE(PG8_SA(0, 1), cA + hstep, voffA);
        if (wr == 1) PG8_BAR;
        PG8_WAIT_V(4); PG8_BAR;
        PG8_STAGE(PG8_SB(1, 0), cB + kstep, voffB); PG8_STAGE(PG8_SA(1, 0), cA + kstep, voffA); PG8_STAGE(PG8_SB(1, 1), cB + hstep + kstep, voffB);
        PG8_WAIT_V(6); PG8_BAR;
    }
    for (;;) {
        const bool has_next = S.next(ui + 1, nxt);
        const char* nA = has_next ? (const char*)g.A + (size_t)nxt.pm * tstep : cA; const char* nB = has_next ? (const char*)g.Bt + (size_t)nxt.pn * tstep : cB;
        for (int t = 0; t < nt; t += 2) {
            const bool last = (t == nt - 2);
            const char* a1 = cA + (size_t)(t + 1) * kstep;
            const char* a2 = last ? nA : cA + (size_t)(t + 2) * kstep; const char* b2 = last ? nB : cB + (size_t)(t + 2) * kstep;
            const char* a3 = a2 + kstep; const char* b3 = b2 + kstep;
            if (last && has_next) S.a_ready(nxt);
            if constexpr (SP2) {
            PG8_LDB(B0, 0, 0); PG8_LDB(B1, 0, 1); PG8_SCHED; PG8_LDA(At, 0, 0); PG8_STAGE(PG8_SA(1, 1), a1 + hstep, voffA);
            PG8_WAIT_V(8); PG8_WAIT_L(0); PG8_BAR; PG8_MMA(0, 0, At, B0); PG8_MMA(0, 1, At, B1); PG8_BAR; PG8_SCHED;
            PG8_LDA(At, 0, 1); PG8_STAGE(PG8_SB(0, 0), b2, voffB); PG8_STAGE(PG8_SB(0, 1), b2 + hstep, voffB); PG8_STAGE(PG8_SA(0, 0), a2, voffA);
            PG8_WAIT_V(8); PG8_WAIT_L(0); PG8_BAR; PG8_MMA(1, 0, At, B0); PG8_MMA(1, 1, At, B1); PG8_BAR; PG8_SCHED;
            PG8_LDB(B0, 1, 0); PG8_LDB(B1, 1, 1); PG8_SCHED; PG8_LDA(At, 1, 0); PG8_STAGE(PG8_SA(0, 1), a2 + hstep, voffA);
            PG8_WAIT_V(8); PG8_WAIT_L(0); PG8_BAR; PG8_MMA(0, 0, At, B0); PG8_MMA(0, 1, At, B1); PG8_BAR; PG8_SCHED;
            PG8_LDA(At, 1, 1); PG8_STAGE(PG8_SB(1, 0), b3, voffB); PG8_STAGE(PG8_SB(1, 1), b3 + hstep, voffB); PG8_STAGE(PG8_SA(1, 0), a3, voffA);
            PG8_WAIT_V(8); PG8_WAIT_L(0); PG8_BAR; PG8_MMA(1, 0, At, B0); PG8_MMA(1, 1, At, B1); PG8_BAR; PG8_SCHED;
            } else {
            PG8_LDB(B0, 0, 0); PG8_SCHED; PG8_LDA(At, 0, 0); PG8_STAGE(PG8_SA(1, 1), a1 + hstep, voffA);
            PG8_WAIT_L(8); PG8_BAR; PG8_WAIT_L(0); PG8_MMA(0, 0, At, B0); PG8_BAR; PG8_SCHED;
            PG8_LDB(B1, 0, 1); PG8_STAGE(PG8_SB(0, 0), b2, voffB);
            PG8_BAR; PG8_WAIT_L(0); PG8_MMA(0, 1, At, B1); PG8_BAR;
            PG8_LDA(At, 0, 1); PG8_STAGE(PG8_SA(0, 0), a2, voffA);
            PG8_BAR; PG8_WAIT_L(0); PG8_MMA(1, 0, At, B0); PG8_BAR; PG8_SCHED;
            PG8_STAGE(PG8_SB(0, 1), b2 + hstep, voffB);
            PG8_WAIT_V(6); PG8_BAR; PG8_MMA(1, 1, At, B1); PG8_BAR;
            PG8_LDB(B0, 1, 0); PG8_SCHED; PG8_LDA(At, 1, 0); PG8_STAGE(PG8_SA(0, 1), a2 + hstep, voffA);
            PG8_WAIT_L(8); PG8_BAR; PG8_WAIT_L(0); PG8_MMA(0, 0, At, B0); PG8_BAR; PG8_SCHED;
            PG8_LDB(B1, 1, 1); PG8_STAGE(PG8_SB(1, 0), b3, voffB);
            PG8_BAR; PG8_WAIT_L(0); PG8_MMA(0, 1, At, B1); PG8_BAR;
            PG8_LDA(At, 1, 1); PG8_STAGE(PG8_SA(1, 0), a3, voffA);
            PG8_BAR; PG8_WAIT_L(0); PG8_MMA(1, 0, At, B0); PG8_BAR; PG8_SCHED;
            PG8_STAGE(PG8_SB(1, 1), b3 + hstep, voffB);
            PG8_WAIT_V(6); PG8_BAR; PG8_MMA(1, 1, At, B1); PG8_BAR;
            }
        }
        if constexpr (ALIGN_EPI) { if (wr == 0) PG8_BAR; }
        if constexpr (!Epi::AFTER_DRAIN) { E(acc, cur, wr, wc, fr, fq); S.done(cur); }
        if (!has_next) break;
#pragma unroll
        for (int a = 0; a < 2; ++a)
#pragma unroll
            for (int b = 0; b < 2; ++b)
#pragma unroll
                for (int m = 0; m < 4; ++m)
#pragma unroll
                    for (int n = 0; n < 2; ++n) acc[a][b][m][n] = (f32x4){0.f, 0.f, 0.f, 0.f};
        cur = nxt; cA = nA; cB = nB; ++ui;
        if constexpr (ALIGN_EPI) { if (wr == 1) PG8_BAR; }
    }
    PG8_WAIT_V(0);
    if constexpr (!ALIGN_EPI) { if (wr == 0) PG8_BAR; }
    PG8_BAR;
    if constexpr (Epi::AFTER_DRAIN) { E.fused(acc, cur, wr, wc, fr, fq, lds, wid, lane); S.done(cur); }
#undef PG8_SA
#undef PG8_SB
#undef PG8_STAGE
#undef PG8_LDA
#undef PG8_LDB
#undef PG8_MMA
#undef PG8_WAIT_V
#undef PG8_WAIT_L
#undef PG8_BAR
#undef PG8_SCHED
}
}
namespace pg8 {
struct EpiP {
    static constexpr bool PERM = true, AFTER_DRAIN = false;
    bf16_t* O; int ldc;
    __device__ __forceinline__ void operator()(const f32x4 (&acc)[2][2][4][2], const Unit& u, int wr, int wc, int fr, int fq) const {
        const int row0 = u.pm * BM + wr * 64 + fr; const int col0 = u.pn * BM + wc * 32 + 8 * fq;
#pragma unroll
        for (int ai = 0; ai < 2; ++ai)
#pragma unroll
            for (int m = 0; m < 4; ++m) { bf16_t* rowp = O + (size_t)(row0 + ai * HALF + m * 16) * ldc + col0;
#pragma unroll
                for (int bj = 0; bj < 2; ++bj) { const f32x4 v0 = acc[ai][bj][m][0], v1 = acc[ai][bj][m][1];
                    u32x4 w; w.x = cvt_pk_bf16(v0[0], v0[1]); w.y = cvt_pk_bf16(v0[2], v0[3]); w.z = cvt_pk_bf16(v1[0], v1[1]); w.w = cvt_pk_bf16(v1[2], v1[3]);
                    *(u32x4*)(rowp + bj * HALF) = w; } }
    }
};
struct EpiY {
    static constexpr bool PERM = false, AFTER_DRAIN = false;
    float* C; int ldc;
    __device__ __forceinline__ void operator()(const f32x4 (&acc)[2][2][4][2], const Unit& u, int wr, int wc, int fr, int fq) const {
        const int row0 = u.pm * BM + wr * 64 + fr, col0 = u.pn * BM + wc * 32 + 4 * fq;
#pragma unroll
        for (int ai = 0; ai < 2; ++ai)
#pragma unroll
            for (int m = 0; m < 4; ++m) { float* rowp = C + (size_t)(row0 + ai * HALF + m * 16) * ldc + col0;
#pragma unroll
                for (int bj = 0; bj < 2; ++bj)
#pragma unroll
                    for (int n = 0; n < 2; ++n) *(f32x4*)(rowp + bj * HALF + n * 16) = acc[ai][bj][m][n]; }
    }
};
struct LatentOrder : StaticOrder {
    __host__ __device__ bool next(int i, Unit& u) const { if (!StaticOrder::next(i, u)) return false; u.pm = u.pm + u.pm / 16 + 1; return true; }
};
}

#ifndef PH_MASK
#define PH_MASK 0xfff
#endif
#ifndef DUP_MASK
#define DUP_MASK 0
#endif
#ifndef MIX_DUP
#define MIX_DUP 0
#endif
#ifndef USE_VALU_SCAN
#define USE_VALU_SCAN 0
#endif
#ifndef SCAN_DUP
#define SCAN_DUP 0
#endif
#ifndef SCAN_XBAR
#define SCAN_XBAR 0
#endif
#ifndef MIX_MASK
#define MIX_MASK 7
#endif
using pg8::bf16_t; using pg8::bf16x8; using pg8::f32x4; using pg8::u32x4;
typedef float f32x2 __attribute__((ext_vector_type(2)));
typedef float f32x16 __attribute__((ext_vector_type(16)));
typedef unsigned u32x2 __attribute__((ext_vector_type(2)));
#define LAS __attribute__((address_space(3)))

constexpr int D = 2048, NBATCH = 4, SEQ = 4096, CTXL = 256, TT = SEQ + CTXL, MROWS = NBATCH * TT;
constexpr int NPW = 7696, NP = 7936, NMOD = 6144;
constexpr float EPS = 1e-6f;
constexpr int C_AQ = 0, C_AFF = 512, C_AFB = 1024, C_AI = 1536, C_BQ = 2048, C_BK = 2560, C_BV = 3072, C_GT = 3584,
              C_CQ = 3840, C_CK = 4864, C_CV = 5120, C_CZ = 5376, C_AG = 6400, C_BO = 6912, C_BZ = 7424;
constexpr int NX = 15 * 256, NY1 = NP - NX, SCAN_WGS = 64;
constexpr size_t WS_WIN  = 0;
constexpr size_t WS_WOUT = WS_WIN  + (size_t)2 * NP * D * 2;
constexpr size_t WS_A    = WS_WOUT + (size_t)2 * D * D * 2;
constexpr size_t WS_P    = WS_A    + (size_t)MROWS * D * 2;
constexpr size_t WS_HCTX = WS_P    + (size_t)MROWS * NP * 2;
constexpr size_t WS_O    = WS_HCTX + (size_t)NBATCH * CTXL * D * 4;
constexpr size_t WS_MOD  = WS_O    + (size_t)2 * MROWS * 1024 * 2;
constexpr size_t WS_BAR  = WS_MOD  + (size_t)2 * 5 * NMOD * 4;
constexpr size_t WS_XBAR = WS_BAR + 1024;
constexpr size_t WS_ROPE = WS_XBAR + 16384;
constexpr size_t WS_END  = WS_ROPE + (size_t)64 * 32 * 8;
constexpr int LDS_BYTES = 131072 + 64;
constexpr int NPHASE = 12;

struct Params { const float* in[14]; float* out; unsigned char* ws; int ph_lo, ph_hi; };

__device__ __forceinline__ float bf2f(unsigned h) { return __uint_as_float(h << 16); }
__device__ __forceinline__ float bflo(unsigned w) { return __uint_as_float(w << 16); }
__device__ __forceinline__ float bfhi(unsigned w) { return __uint_as_float(w & 0xffff0000u); }
typedef __bf16 bf16v2_t __attribute__((ext_vector_type(2)));
__device__ __forceinline__ unsigned pk2(float a, float b) { const f32x2 v = {a, b}; const bf16v2_t r = __builtin_convertvector(v, bf16v2_t); return __builtin_bit_cast(unsigned, r); }
__device__ __forceinline__ float sigm(float x) { return __builtin_amdgcn_rcpf(1.f + __expf(-x)); }
__device__ __forceinline__ float siluf(float x) { return x * __builtin_amdgcn_rcpf(1.f + __expf(-x)); }
__device__ __forceinline__ float wave_sum(float v) {
#pragma unroll
    for (int o = 1; o < 64; o <<= 1) v += __shfl_xor(v, o);
    return v;
}
__device__ __forceinline__ float rdlane_f(float v, int l) { return __int_as_float(__builtin_amdgcn_readlane(__float_as_int(v), l)); }
__device__ __forceinline__ void st_b64_untracked(void* ptr, u32x2 v) { asm volatile("global_store_dwordx2 %0, %1, off" :: "v"(ptr), "v"(v) : "memory"); }
__device__ __forceinline__ void touch4(unsigned a, unsigned b, unsigned c, unsigned d) { asm volatile("" :: "v"(a), "v"(b), "v"(c), "v"(d)); }
#define LDS_WAIT() asm volatile("s_waitcnt lgkmcnt(0)" ::: "memory")

__device__ __forceinline__ int orig_col(int c) {
    return c < 2048 ? c : (c < 3584 ? c + 512 : (c < 3600 ? c + 1024 : (c < 3840 ? -1 : (c < 6400 ? c + 1296 : (c < 6912 ? c - 4352 : (c < 7424 ? c - 2816 : c - 2800))))));
}
template <bool REMAP>
__device__ __forceinline__ void p0_transpose_item(const float* W, int K, int N, bf16_t* WT, LAS float* scr, int item, int nblk, int lane) {
    const int kb = item / nblk, nb = item % nblk, k0 = 64 * kb, n0 = 32 * nb;
    const int cc = n0 + (lane & 31); const int oc = REMAP ? orig_col(cc) : cc;
    float wv_[32];
#pragma unroll
    for (int i = 0; i < 32; ++i) { const int kk = 2 * i + (lane >> 5); wv_[i] = (oc >= 0) ? W[(size_t)(k0 + kk) * N + oc] : 0.f; }
#pragma unroll
    for (int i = 0; i < 32; ++i) { const int kk = 2 * i + (lane >> 5); scr[kk * 33 + (lane & 31)] = wv_[i]; }
    LDS_WAIT(); asm volatile("" ::: "memory");
    const int c = lane & 7;
#pragma unroll
    for (int j = 0; j < 4; ++j) { const int n = (lane >> 3) + 8 * j; const LAS float* s = scr + (8 * c) * 33 + n;
        u32x4 o; o.x = pk2(s[0 * 33], s[1 * 33]); o.y = pk2(s[2 * 33], s[3 * 33]); o.z = pk2(s[4 * 33], s[5 * 33]); o.w = pk2(s[6 * 33], s[7 * 33]);
        *(u32x4*)(WT + (size_t)(n0 + n) * K + k0 + 8 * c) = o; }
    LDS_WAIT(); asm volatile("" ::: "memory");
}
__device__ __forceinline__ void weight_transposes(const Params& p, LAS unsigned char* lds, int l, int gw, int NGW) {
    const int lane = opaque_tid() & 63, wave = (opaque_tid() >> 6) & 7;
    LAS float* scr = (LAS float*)(lds + wave * 16384);
    bf16_t* WinT = (bf16_t*)(p.ws + WS_WIN); bf16_t* WoutT = (bf16_t*)(p.ws + WS_WOUT);
    constexpr int I_IN = (D / 64) * (NP / 32), I_OUT = (D / 64) * (D / 32), NITEMS = I_IN + I_OUT;
    for (int it = gw; it < NITEMS; it += NGW) {
        if (it < I_IN) p0_transpose_item<true>(p.in[8] + (size_t)l * D * NPW, D, NPW, WinT + (size_t)l * NP * D, scr, it, NP / 32, lane);
        else p0_transpose_item<false>(p.in[13] + (size_t)l * D * D, D, D, WoutT + (size_t)l * D * D, scr, it - I_IN, D / 32, lane);
    }
}
__device__ __forceinline__ void p0_prologue(const Params& p, LAS unsigned char* lds) {
    const int tid = opaque_tid(), lane = tid & 63, wave = tid >> 6;
    LAS float* scr = (LAS float*)(lds + wave * 16384);
    const int gw = blockIdx.x * 8 + wave, NGW = gridDim.x * 8;
    bf16_t* WinT = (bf16_t*)(p.ws + WS_WIN); bf16_t* WoutT = (bf16_t*)(p.ws + WS_WOUT);
    float* mod = (float*)(p.ws + WS_MOD);
    if (blockIdx.x == 0) {
        float* tab = (float*)(p.ws + WS_ROPE);
        for (int idx = tid; idx < 64 * 32; idx += 512) { const int pos = idx >> 5, i = idx & 31;
            const float inv = __builtin_amdgcn_exp2f(-(float)i * (13.287712379549449f / 32.f)); const float ang = (float)pos * inv;
            tab[2 * idx] = __cosf(ang); tab[2 * idx + 1] = __sinf(ang); }
    }
    constexpr int MOD_TASKS = 2 * 96 * 16;
    for (int task = gw; task < MOD_TASKS; task += NGW) {
        const int l = task / 1536, r = task % 1536, cgp = r % 96, kr = r / 96, n = cgp * 64 + lane, k0 = kr * 128;
        for (int idx = lane; idx < 640; idx += 64) { const int v = idx >> 7, kk = idx & 127; const float s = (v < 4) ? p.in[1][v * D + k0 + kk] : p.in[3][k0 + kk]; scr[idx] = siluf(s); }
        LDS_WAIT(); asm volatile("" ::: "memory");
        float acc[5] = {0.f, 0.f, 0.f, 0.f, 0.f};
        const float* wp = p.in[4] + (size_t)l * D * NMOD + (size_t)k0 * NMOD + n;
#pragma unroll 8
        for (int kk = 0; kk < 128; ++kk) { const float w = wp[(size_t)kk * NMOD];
#pragma unroll
            for (int v = 0; v < 5; ++v) acc[v] += scr[v * 128 + kk] * w; }
        if (kr == 0) { const float bb = p.in[5][l * NMOD + n];
#pragma unroll
            for (int v = 0; v < 5; ++v) acc[v] += bb; }
#pragma unroll
        for (int v = 0; v < 5; ++v) atomicAdd(mod + ((size_t)l * 5 + v) * NMOD + n, acc[v]);
        LDS_WAIT(); asm volatile("" ::: "memory");
    }
    const bool defer1 = (int)gridDim.x > 2 * SCAN_WGS;
    weight_transposes(p, lds, 0, gw, NGW);
    if (!defer1) weight_transposes(p, lds, 1, gw, NGW);
}

__device__ __forceinline__ void post_stage(f32x4 (&v)[8], const f32x4 (&y)[8], float rs, const float* __restrict__ gp, const float* __restrict__ gate, float* __restrict__ dst, int lane, bool nt) {
#pragma unroll
    for (int h2 = 0; h2 < 2; ++h2) {
        f32x4 g[4], ga[4];
#pragma unroll
        for (int j = 0; j < 4; ++j) { g[j] = *((const f32x4*)gp + lane + 64 * (4 * h2 + j)); ga[j] = *((const f32x4*)gate + lane + 64 * (4 * h2 + j)); }
#pragma unroll
        for (int j = 0; j < 4; ++j) { const int jj = 4 * h2 + j; v[jj] = v[jj] + ga[j] * (y[jj] * rs * g[j]); if (nt) __builtin_nontemporal_store(v[jj], (f32x4*)dst + lane + 64 * jj); else *((f32x4*)dst + lane + 64 * jj) = v[jj]; }
    }
}
__device__ __forceinline__ void pre_stage(const f32x4 (&v)[8], float rs, const float* __restrict__ gp, const float* __restrict__ sc, const float* __restrict__ sh, u32x2* __restrict__ ar, int lane) {
#pragma unroll
    for (int h2 = 0; h2 < 2; ++h2) {
        f32x4 g[4], s1[4], s0[4];
#pragma unroll
        for (int j = 0; j < 4; ++j) { g[j] = *((const f32x4*)gp + lane + 64 * (4 * h2 + j)); s1[j] = *((const f32x4*)sc + lane + 64 * (4 * h2 + j)); s0[j] = *((const f32x4*)sh + lane + 64 * (4 * h2 + j)); }
#pragma unroll
        for (int j = 0; j < 4; ++j) { const f32x4 o = (v[4 * h2 + j] * rs * g[j]) * (s1[j] + 1.f) + s0[j]; u32x2 w; w.x = pk2(o.x, o.y); w.y = pk2(o.z, o.w); ar[lane + 64 * (4 * h2 + j)] = w; }
    }
}
template <int MODE, int NR>
__device__ __forceinline__ void row_body(const Params& p, int m0, int mstride, int lane) {
    const float* mod = (const float*)(p.ws + WS_MOD);
    const bf16_t* Yout = (const bf16_t*)(p.ws + WS_P);
    float* hctx = (float*)(p.ws + WS_HCTX);
    bf16_t* A = (bf16_t*)(p.ws + WS_A);
    f32x4 v[NR][8]; f32x4 y[NR][8]; int mv[NR]; float* dst[NR]; int mrow[NR];
#pragma unroll
    for (int q = 0; q < NR; ++q) {
        const int m = m0 + q * mstride; mrow[q] = m;
        const int b = m / TT, tok = m - b * TT; const bool isctx = tok < CTXL;
        mv[q] = isctx ? 4 : b;
        const float* src;
        if (MODE <= 1) src = isctx ? p.in[2] + ((size_t)b * CTXL + tok) * D : p.in[0] + ((size_t)b * SEQ + (tok - CTXL)) * D;
        else src = p.out + ((size_t)b * SEQ + (tok - CTXL)) * D;
        if (MODE == 0) dst[q] = nullptr;
        else if (MODE == 1) dst[q] = isctx ? hctx + ((size_t)b * CTXL + tok) * D : p.out + ((size_t)b * SEQ + (tok - CTXL)) * D;
        else dst[q] = p.out + ((size_t)b * SEQ + (tok - CTXL)) * D;
#pragma unroll
        for (int j = 0; j < 8; ++j) v[q][j] = __builtin_nontemporal_load((const f32x4*)src + lane + 64 * j);
        if (MODE >= 1) { const bf16_t* yr = Yout + (size_t)m * D;
#pragma unroll
            for (int j = 0; j < 8; ++j) { const u32x2 yw = __builtin_nontemporal_load((const u32x2*)yr + lane + 64 * j); y[q][j] = (f32x4){bflo(yw.x), bfhi(yw.x), bflo(yw.y), bfhi(yw.y)}; } }
    }
    if (MODE >= 1) {
        const int lpost = MODE - 1; const float* gp = p.in[7] + lpost * D;
#pragma unroll
        for (int q = 0; q < NR; ++q) {
            const float* gate = mod + ((size_t)lpost * 5 + mv[q]) * NMOD + 2 * D; float ss = 0.f;
#pragma unroll
            for (int j = 0; j < 8; ++j) ss += (y[q][j].x * y[q][j].x + y[q][j].y * y[q][j].y) + (y[q][j].z * y[q][j].z + y[q][j].w * y[q][j].w);
            const float rs = __builtin_amdgcn_rsqf(wave_sum(ss) * (1.f / D) + EPS);
            post_stage(v[q], y[q], rs, gp, gate, dst[q], lane, MODE == 2);
        }
    }
    if (MODE <= 1) {
        const int lpre = MODE; const float* gp = p.in[6] + lpre * D;
#pragma unroll
        for (int q = 0; q < NR; ++q) {
            const float* sh = mod + ((size_t)lpre * 5 + mv[q]) * NMOD; const float* sc = sh + D; float ss = 0.f;
#pragma unroll
            for (int j = 0; j < 8; ++j) ss += (v[q][j].x * v[q][j].x + v[q][j].y * v[q][j].y) + (v[q][j].z * v[q][j].z + v[q][j].w * v[q][j].w);
            const float rs = __builtin_amdgcn_rsqf(wave_sum(ss) * (1.f / D) + EPS);
            pre_stage(v[q], rs, gp, sc, sh, (u32x2*)(A + (size_t)mrow[q] * D), lane);
        }
    }
}
template <int MODE>
__device__ __forceinline__ void row_phase(const Params& p) {
    const int tid = opaque_tid(), lane = tid & 63, wave = tid >> 6;
    const int gw = blockIdx.x * 8 + wave, NGW = gridDim.x * 8;
    if (MODE == 2) {
        int r = gw;
        for (; r + NGW < NBATCH * SEQ; r += 2 * NGW) { const int ma = (r / SEQ) * TT + CTXL + (r % SEQ), r2 = r + NGW, mb = (r2 / SEQ) * TT + CTXL + (r2 % SEQ); row_body<MODE, 2>(p, ma, mb - ma, lane); }
        if (r < NBATCH * SEQ) row_body<MODE, 1>(p, (r / SEQ) * TT + CTXL + (r % SEQ), 0, lane);
    } else if (MODE == 0) {
        int m = gw;
        for (; m + 3 * NGW < MROWS; m += 4 * NGW) row_body<MODE, 4>(p, m, NGW, lane);
        for (; m < MROWS; m += NGW) row_body<MODE, 1>(p, m, 0, lane);
    } else {
        int m = gw;
        for (; m + NGW < MROWS; m += 2 * NGW) row_body<MODE, 2>(p, m, NGW, lane);
        if (m < MROWS) row_body<MODE, 1>(p, m, 0, lane);
    }
}

constexpr int TC = 16, NCH = TT / TC;
constexpr int SC_A = 0, SC_B = SC_A + TC * 128 * 4, SC_Q = SC_B + TC * 128 * 4, SC_V = SC_Q + TC * 128 * 4, SC_O = SC_V + TC * 36 * 4, SC_N = SC_O + TC * 8 * 32 * 4, SC_END = SC_N + TC * 64 * 4;
template <int CTRL> __device__ __forceinline__ float dpp_quad(float v) { return __int_as_float(__builtin_amdgcn_mov_dpp(__float_as_int(v), CTRL, 0xf, 0xf, true)); }

template <int BR>
__device__ __forceinline__ void scan_unit(const Params& p, int layer, int unit, LAS unsigned char* lds) {
    const int tid = opaque_tid(), lane = tid & 63, wave = tid >> 6;
    const int dir = (unit >> 6) & 1, b = (unit >> 4) & 3, h = (unit >> 2) & 3, colq = unit & 3;
    const bf16_t* P = (const bf16_t*)(p.ws + WS_P);
    bf16_t* Ob = (bf16_t*)(p.ws + WS_O) + (size_t)dir * MROWS * 1024 + BR * 512 + h * 128 + colq * 32;
    LAS float* SA = (LAS float*)(lds + SC_A); LAS float* SB = (LAS float*)(lds + SC_B); LAS float* SQ = (LAS float*)(lds + SC_Q);
    LAS float* SV = (LAS float*)(lds + SC_V); LAS float* OB = (LAS float*)(lds + SC_O); LAS float* NBF = (LAS float*)(lds + SC_N);
    const int ts = tid >> 5, lj = tid & 31;
    float lb[4] = {0.f, 0.f, 0.f, 0.f};
    float cwq[3][4], cwk[3][4]; float bias_i = 0.f, bias_f = 0.f;
    if (BR == 0) {
        if (layer == 1) {
#pragma unroll
            for (int e = 0; e < 4; ++e) { const int idx = dir * 512 + h * 128 + 4 * lj + e; lb[e] = sigm(p.in[9][1024 + idx] - p.in[9][idx]); }
        }
    } else {
        const float* cw = p.in[10] + (size_t)layer * 3 * 1024;
#pragma unroll
        for (int tp = 0; tp < 3; ++tp)
#pragma unroll
            for (int e = 0; e < 4; ++e) { cwq[tp][e] = cw[tp * 1024 + h * 128 + 4 * lj + e]; cwk[tp][e] = cw[tp * 1024 + 512 + h * 128 + 4 * lj + e]; }
        bias_i = p.in[11][layer * 16 + (2 * dir) * 4 + h]; bias_f = p.in[11][layer * 16 + (2 * dir + 1) * 4 + h];
    }
    u32x2 rq[3], rk[3]; unsigned rv = 0, rgi = 0, rgf = 0; int mrow = 0; float okf[3] = {1.f, 1.f, 1.f};
    auto issue = [&](int ch) {
        const int t = ch * TC + ts; const int tok = dir ? (t < CTXL ? (CTXL - 1 - t) : (TT + CTXL - 1 - t)) : t;
        mrow = b * TT + tok;
        const bf16_t* pr = P + (size_t)mrow * NP;
        if (BR == 0) {
            rq[0] = *(const u32x2*)(pr + C_AQ + h * 128 + 4 * lj);
            rk[0] = *(const u32x2*)(pr + (dir ? C_AFB : C_AFF) + h * 128 + 4 * lj);
            rv = pr[C_AI + h * 128 + colq * 32 + lj];
        } else {
            const int lo = tok < CTXL ? 0 : CTXL, hi = tok < CTXL ? CTXL - 1 : TT - 1;
#pragma unroll
            for (int tp = 0; tp < 3; ++tp) { const int tn = tok + tp - 1; const bool ok = (tn >= lo) && (tn <= hi); const bf16_t* pn = P + (size_t)(b * TT + (ok ? tn : tok)) * NP;
                rq[tp] = *(const u32x2*)(pn + C_BQ + h * 128 + 4 * lj); rk[tp] = *(const u32x2*)(pn + C_BK + h * 128 + 4 * lj); okf[tp] = ok ? 1.f : 0.f; }
            rv = pr[C_BV + h * 128 + colq * 32 + lj];
            rgi = pr[C_GT + (2 * dir) * 4 + h]; rgf = pr[C_GT + (2 * dir + 1) * 4 + h];
        }
    };
    auto convert = [&]() {
        f32x4 av, bv, qv; float vv;
        if (BR == 0) {
            const float zq[4] = {bflo(rq[0].x), bfhi(rq[0].x), bflo(rq[0].y), bfhi(rq[0].y)};
            const float zf[4] = {bflo(rk[0].x), bfhi(rk[0].x), bflo(rk[0].y), bfhi(rk[0].y)};
#pragma unroll
            for (int e = 0; e < 4; ++e) { const float kk = (1.f - lb[e]) * sigm(-zf[e]); bv[e] = kk; av[e] = 1.f - kk; qv[e] = siluf(zq[e]); }
            vv = bf2f(rv);
        } else {
            const float fg = sigm(bf2f(rgf) + bias_f), ig = __expf(bf2f(rgi) + bias_i);
            float cq[4] = {0.f, 0.f, 0.f, 0.f}, ck[4] = {0.f, 0.f, 0.f, 0.f};
#pragma unroll
            for (int tp = 0; tp < 3; ++tp) {
                const float xq[4] = {bflo(rq[tp].x), bfhi(rq[tp].x), bflo(rq[tp].y), bfhi(rq[tp].y)};
                const float xk[4] = {bflo(rk[tp].x), bfhi(rk[tp].x), bflo(rk[tp].y), bfhi(rk[tp].y)};
#pragma unroll
                for (int e = 0; e < 4; ++e) { cq[e] += (cwq[tp][e] * okf[tp]) * xq[e]; ck[e] += (cwk[tp][e] * okf[tp]) * xk[e]; }
            }
#pragma unroll
            for (int e = 0; e < 4; ++e) { av[e] = fg; bv[e] = siluf(ck[e]); qv[e] = siluf(cq[e]) * 0.08838834764831845f; }
            vv = bf2f(rv) * ig;
            if (lj == 0) SV[ts * 36 + 32] = ig;
        }
        *(LAS f32x4*)(SA + ts * 128 + 4 * lj) = av; *(LAS f32x4*)(SB + ts * 128 + 4 * lj) = bv; *(LAS f32x4*)(SQ + ts * 128 + 4 * lj) = qv;
        SV[ts * 36 + lj] = vv;
    };
    const int cp = lane >> 2, dq = lane & 3, d0 = wave * 16 + dq * 4;
    f32x2 S[2][2]; S[0][0] = S[0][1] = S[1][0] = S[1][1] = (f32x2){0.f, 0.f};
    issue(0); convert();
    __syncthreads();
    f32x2 nn = {0.f, 0.f};
    for (int ch = 0; ch < NCH; ++ch) {
        const int mrow_cur = mrow;
        if (ch + 1 < NCH) issue(ch + 1);
        f32x4 ga[2][4], gb[2][4], gq[2][4]; f32x2 gv[2][4];
#define SC_LOADG(bufi, g) do { _Pragma("unroll") for (int k = 0; k < 4; ++k) { const int s_ = 4 * (g) + k; \
            ga[bufi][k] = *(const LAS f32x4*)(SA + s_ * 128 + d0); gb[bufi][k] = *(const LAS f32x4*)(SB + s_ * 128 + d0); gq[bufi][k] = *(const LAS f32x4*)(SQ + s_ * 128 + d0); \
            gv[bufi][k] = *(const LAS f32x2*)(SV + s_ * 36 + 2 * cp); } } while (0)
        SC_LOADG(0, 0);
#pragma unroll
        for (int g = 0; g < 4; ++g) {
            const int cb = g & 1;
            if (g < 3) SC_LOADG(cb ^ 1, g + 1);
            float ov[4];
#pragma unroll
            for (int k = 0; k < 4; ++k) {
                const f32x4 a = ga[cb][k], bb = gb[cb][k], q = gq[cb][k]; const f32x2 v = gv[cb][k];
                const f32x2 a0 = {a.x, a.y}, a1 = {a.z, a.w}, b0 = {bb.x, bb.y}, b1 = {bb.z, bb.w}, q0 = {q.x, q.y}, q1 = {q.z, q.w};
                float o[2];
#pragma unroll
                for (int c = 0; c < 2; ++c) {
                    const f32x2 vc = {v[c], v[c]};
                    S[c][0] = a0 * S[c][0] + b0 * vc; S[c][1] = a1 * S[c][1] + b1 * vc;
                    const f32x2 t2 = S[c][0] * q0 + S[c][1] * q1; o[c] = t2.x + t2.y;
                }
                o[0] += dpp_quad<0xB1>(o[0]); o[1] += dpp_quad<0xB1>(o[1]);
                o[0] += dpp_quad<0x4E>(o[0]); o[1] += dpp_quad<0x4E>(o[1]);
                ov[k] = (dq & 1) ? o[1] : o[0];
            }
#pragma unroll
            for (int k = 0; k < 4; ++k) OB[((4 * g + k) * 8 + wave) * 32 + 2 * cp + (dq & 1)] = ov[k];
        }
        if (BR == 1 && wave == 7) {
#pragma unroll
            for (int s = 0; s < TC; ++s) {
                const f32x2 b2 = *(const LAS f32x2*)(SB + s * 128 + 2 * lane), q2 = *(const LAS f32x2*)(SQ + s * 128 + 2 * lane);
                const float fg = SA[s * 128], ig = SV[s * 36 + 32];
                nn = nn * fg + b2 * ig;
                NBF[s * 64 + lane] = nn.x * q2.x + nn.y * q2.y;
            }
        }
        __syncthreads();
        if (ch + 1 < NCH) convert();
        {
            float num = 0.f;
#pragma unroll
            for (int w = 0; w < 8; ++w) num += OB[(ts * 8 + w) * 32 + lj];
            if (BR == 1) { float den = NBF[ts * 64 + lj] + NBF[ts * 64 + 32 + lj];
                den += __shfl_xor(den, 1); den += __shfl_xor(den, 2); den += __shfl_xor(den, 4); den += __shfl_xor(den, 8); den += __shfl_xor(den, 16);
                num = num / fmaxf(fabsf(den), 1.f); }
            Ob[(size_t)mrow_cur * 1024 + lj] = (bf16_t)(pk2(num, 0.f) & 0xffffu);
        }
        __syncthreads();
    }
#undef SC_LOADG
}

#define MFMA32(a, b, c) __builtin_amdgcn_mfma_f32_32x32x16_bf16((a), (b), (c), 0, 0, 0)
constexpr int ML = 32, MNCH = TT / ML;
constexpr int MS_ROW = 272, MS_TROW = 80;
constexpr int MS_QT = 0, MS_BT = MS_QT + 32 * MS_ROW, MS_BTT = MS_BT + 32 * MS_ROW, MS_VT = MS_BTT + 128 * MS_TROW, MS_AL = MS_VT + 128 * MS_TROW,
              MS_IV = MS_AL + 512, MS_NV = MS_IV + 128, MS_XA = MS_NV + 1024, MS_XO = MS_XA + 4608, MS_GRP = MS_XO + 16384;
__device__ __forceinline__ bf16x8 pack8(const f32x16& x, int s) {
    u32x4 w; w.x = pk2(x[8 * s], x[8 * s + 1]); w.y = pk2(x[8 * s + 2], x[8 * s + 3]); w.z = pk2(x[8 * s + 4], x[8 * s + 5]); w.w = pk2(x[8 * s + 6], x[8 * s + 7]);
    return __builtin_bit_cast(bf16x8, w);
}
__device__ __forceinline__ bf16x8 ld2x64(const LAS unsigned char* p0) {
    const u32x2 lo = *(const LAS u32x2*)(p0), hi = *(const LAS u32x2*)(p0 + 16);
    u32x4 w; w.x = lo.x; w.y = lo.y; w.z = hi.x; w.w = hi.y; return __builtin_bit_cast(bf16x8, w);
}
template <int BR>
__device__ __forceinline__ void scan_mfma(const Params& p, int layer, int seq, LAS unsigned char* lds) {
    const int tid = opaque_tid(), lane = tid & 63, wave = __builtin_amdgcn_readfirstlane(tid >> 6), wv = wave & 3, dh = wave >> 2, r = lane & 31, hh = lane >> 5;
    const int dir = (seq >> 4) & 1, b = (seq >> 2) & 3, h = seq & 3;
    LAS float* AL = (LAS float*)(lds + MS_AL); LAS float* IV = (LAS float*)(lds + MS_IV); LAS float* NV = (LAS float*)(lds + MS_NV); LAS float* XA = (LAS float*)(lds + MS_XA);
    LAS float* XO = (LAS float*)(lds + MS_XO);
    const bf16_t* P = (const bf16_t*)(p.ws + WS_P);
    bf16_t* Ob = (bf16_t*)(p.ws + WS_O) + (size_t)dir * MROWS * 1024 + BR * 512 + h * 128;
    const int colA = h * 128 + 2 * lane;
    const int cF = dir ? C_AFB : C_AFF;
    float lb[2] = {0.f, 0.f}; float cwq[3][2], cwk[3][2]; float bias_g = 0.f;
    if (BR == 0) { if (layer == 1) {
#pragma unroll
            for (int e = 0; e < 2; ++e) { const int idx = dir * 512 + colA + e; lb[e] = sigm(p.in[9][1024 + idx] - p.in[9][idx]); } }
    } else {
        const float* cw = p.in[10] + (size_t)layer * 3 * 1024;
#pragma unroll
        for (int tp = 0; tp < 3; ++tp)
#pragma unroll
            for (int e = 0; e < 2; ++e) { cwq[tp][e] = cw[tp * 1024 + colA + e]; cwk[tp][e] = cw[tp * 1024 + 512 + colA + e]; }
        bias_g = p.in[11][layer * 16 + 8 * dir + 4 * (lane & 1) + h];
    }
    unsigned rq[2][6], rk[2][6], rv[2][4], rg[2] = {0u, 0u}; float oklo[2] = {1.f, 1.f}, okhi[2] = {1.f, 1.f};
    auto tok_of = [&](int t) { return dir ? (t < CTXL ? (CTXL - 1 - t) : (TT + CTXL - 1 - t)) : t; };
    const char* Pb = (const char*)P;
#define LDU32(byteoff) (*(const unsigned*)(Pb + (unsigned)(byteoff)))
    auto issue = [&](int ch, auto SETC) {
        constexpr int st = decltype(SETC)::value;
        const int t0 = (ch < MNCH ? ch : MNCH - 1) * ML + 4 * wave;
        constexpr unsigned RB = 2u * NP;
        if (BR == 0) {
            const unsigned o0 = ((unsigned)(b * TT + tok_of(t0)) * (unsigned)NP + (unsigned)colA) * 2u;
#pragma unroll
            for (int k = 0; k < 4; ++k) { const unsigned o = dir ? o0 - (unsigned)k * RB : o0 + (unsigned)k * RB;
                rq[st][k] = LDU32(o + 2u * C_AQ); rk[st][k] = LDU32(o + 2u * (unsigned)cF); rv[st][k] = LDU32(o + 2u * C_AI); }
        } else {
            const int tk0 = dir ? tok_of(t0 + 3) : tok_of(t0);
            const int lo = tk0 < CTXL ? 0 : CTXL, hi = tk0 < CTXL ? CTXL - 1 : TT - 1;
            oklo[st] = (tk0 > lo) ? 1.f : 0.f; okhi[st] = (tk0 + 3 < hi) ? 1.f : 0.f;
            const unsigned o0 = ((unsigned)(b * TT + tk0) * (unsigned)NP + (unsigned)colA) * 2u;
#pragma unroll
            for (int w = 0; w < 6; ++w) { const unsigned o = (w == 0) ? (tk0 > lo ? o0 - RB : o0) : ((w == 5) ? (tk0 + 3 < hi ? o0 + 4u * RB : o0 + 3u * RB) : o0 + (unsigned)(w - 1) * RB);
                rq[st][w] = LDU32(o + 2u * C_BQ); rk[st][w] = LDU32(o + 2u * C_BK); }
#pragma unroll
            for (int k = 0; k < 4; ++k) { const unsigned o = o0 + (unsigned)(dir ? 3 - k : k) * RB; rv[st][k] = LDU32(o + 2u * C_BV); }
            { const int k = (lane >> 1) & 3; const unsigned o = ((unsigned)(b * TT + tk0 + (dir ? 3 - k : k)) * (unsigned)NP + (unsigned)(C_GT + 8 * dir + 4 * (lane & 1) + h)) * 2u; rg[st] = *(const unsigned short*)(Pb + o); }
        }
    };
#undef LDU32
    float gvec = 0.f; float hb[4][2] = {{0.f, 0.f}, {0.f, 0.f}, {0.f, 0.f}, {0.f, 0.f}};
    auto part1 = [&](auto SETC) {
        constexpr int st = decltype(SETC)::value;
        float run0 = 1.f, run1 = 1.f;
        if (BR == 0) {
#pragma unroll
            for (int k = 0; k < 4; ++k) { hb[k][0] = (1.f - lb[0]) * sigm(-bflo(rk[st][k])); hb[k][1] = (1.f - lb[1]) * sigm(-bfhi(rk[st][k])); run0 *= (1.f - hb[k][0]); run1 *= (1.f - hb[k][1]); }
        } else {
            gvec = (lane & 1) ? sigm(bf2f(rg[st]) + bias_g) : __expf(bf2f(rg[st]) + bias_g);
#pragma unroll
            for (int k = 0; k < 4; ++k) run0 *= rdlane_f(gvec, 2 * k + 1);
            run1 = run0;
        }
        *(LAS f32x2*)(XA + wave * 128 + 2 * lane) = (f32x2){run0, run1};
        touch4(rq[st][0], rq[st][1], rq[st][2], rq[st][3]); touch4(rv[st][0], rv[st][1], rv[st][2], rv[st][3]);
        if (BR == 1) { touch4(rq[st][4], rq[st][5], rk[st][0], rk[st][1]); touch4(rk[st][2], rk[st][3], rk[st][4], rk[st][5]); }
    };
    auto part2 = [&](auto SETC) {
        constexpr int st = decltype(SETC)::value;
        float run0 = 1.f, run1 = 1.f;
#pragma unroll
        for (int qd = 0; qd < 7; ++qd) if (qd < wave) { const f32x2 x = *(const LAS f32x2*)(XA + qd * 128 + 2 * lane); run0 *= x.x; run1 *= x.y; }
        unsigned bt0[2], bt1[2], vt0[2], vt1[2]; float bprev0 = 0.f, bprev1 = 0.f, vprev0 = 0.f, vprev1 = 0.f;
        if (BR == 1) { if (oklo[st] == 0.f) { rq[st][0] = 0u; rk[st][0] = 0u; } if (okhi[st] == 0.f) { rq[st][5] = 0u; rk[st][5] = 0u; } }
#pragma unroll
        for (int k = 0; k < 4; ++k) {
            float q0, q1, b0, b1, v0, v1;
            if (BR == 0) {
                b0 = hb[k][0]; b1 = hb[k][1];
                run0 *= (1.f - b0); run1 *= (1.f - b1);
                q0 = siluf(bflo(rq[st][k])); q1 = siluf(bfhi(rq[st][k])); v0 = bflo(rv[st][k]); v1 = bfhi(rv[st][k]);
            } else {
                const float ig = rdlane_f(gvec, 2 * k), fg = rdlane_f(gvec, 2 * k + 1);
                const int wc = 1 + (dir ? 3 - k : k);
                float cq0 = 0.f, cq1 = 0.f, ck0 = 0.f, ck1 = 0.f;
#pragma unroll
                for (int tp = 0; tp < 3; ++tp) { const int w = wc + tp - 1;
                    cq0 += cwq[tp][0] * bflo(rq[st][w]); cq1 += cwq[tp][1] * bfhi(rq[st][w]); ck0 += cwk[tp][0] * bflo(rk[st][w]); ck1 += cwk[tp][1] * bfhi(rk[st][w]); }
                run0 *= fg; run1 = run0;
                b0 = siluf(ck0); b1 = siluf(ck1); q0 = siluf(cq0) * 0.08838834764831845f; q1 = siluf(cq1) * 0.08838834764831845f;
                v0 = bflo(rv[st][k]) * ig; v1 = bfhi(rv[st][k]) * ig;
            }
            const float A0 = fmaxf(run0, 1e-30f), A1 = fmaxf(run1, 1e-30f);
            const float bh0 = b0 * __builtin_amdgcn_rcpf(A0), bh1 = b1 * __builtin_amdgcn_rcpf(A1);
            *(LAS unsigned*)(lds + MS_QT + (4 * wave + k) * MS_ROW + 4 * lane) = pk2(q0 * A0, q1 * A1);
            *(LAS unsigned*)(lds + MS_BT + (4 * wave + k) * MS_ROW + 4 * lane) = pk2(bh0, bh1);
            if (k & 1) { bt0[k >> 1] = pk2(bprev0, bh0); bt1[k >> 1] = pk2(bprev1, bh1); vt0[k >> 1] = pk2(vprev0, v0); vt1[k >> 1] = pk2(vprev1, v1); }
            else { bprev0 = bh0; bprev1 = bh1; vprev0 = v0; vprev1 = v1; }
        }
        *(LAS u32x2*)(lds + MS_BTT + (2 * lane) * MS_TROW + 8 * wave) = (u32x2){bt0[0], bt0[1]};
        *(LAS u32x2*)(lds + MS_BTT + (2 * lane + 1) * MS_TROW + 8 * wave) = (u32x2){bt1[0], bt1[1]};
        *(LAS u32x2*)(lds + MS_VT + (2 * lane) * MS_TROW + 8 * wave) = (u32x2){vt0[0], vt0[1]};
        *(LAS u32x2*)(lds + MS_VT + (2 * lane + 1) * MS_TROW + 8 * wave) = (u32x2){vt1[0], vt1[1]};
        if (wave == 7) *(LAS f32x2*)(AL + 2 * lane) = (f32x2){fmaxf(run0, 1e-30f), fmaxf(run1, 1e-30f)};
        if (BR == 1 && lane < 8 && !(lane & 1)) IV[4 * wave + (lane >> 1)] = gvec;
    };
    const std::integral_constant<int, 0> IC0{}; const std::integral_constant<int, 1> IC1{};
    f32x16 S[2];
#pragma unroll
    for (int k = 0; k < 2; ++k)
#pragma unroll
        for (int i = 0; i < 16; ++i) S[k][i] = 0.f;
    if (BR == 1 && tid < 128) { NV[tid] = 0.f; }
    if (tid < 128) XA[8 * 128 + tid] = 1.f;
    __syncthreads();
    issue(0, IC0); issue(1, IC1); part1(IC0);
    __syncthreads();
    part2(IC0);
    __builtin_amdgcn_sched_barrier(0);
    issue(2, IC0);
    __syncthreads();
    auto iter = [&](int ch, auto SETN) {
        const int nvc = (ch & 1) * 128, nvn = 128 - nvc;
        if (dh == 0) __builtin_amdgcn_s_setprio(2);
        f32x16 ot, ot2; float den = 0.f;
#pragma unroll
        for (int i = 0; i < 16; ++i) { ot[i] = 0.f; ot2[i] = 0.f; }
#pragma unroll
        for (int ks = 0; ks < 2; ++ks) {
            const bf16x8 qa = ld2x64(lds + MS_QT + r * MS_ROW + (32 * (2 * dh) + 16 * ks + 4 * hh) * 2), qb = ld2x64(lds + MS_QT + r * MS_ROW + (32 * (2 * dh + 1) + 16 * ks + 4 * hh) * 2);
            ot = MFMA32(pack8(S[0], ks), qa, ot); ot2 = MFMA32(pack8(S[1], ks), qb, ot2);
        }
        if (dh == 0) {
            f32x16 pt, pt2;
#pragma unroll
            for (int i = 0; i < 16; ++i) { pt[i] = 0.f; pt2[i] = 0.f; }
#pragma unroll
            for (int k = 0; k < 4; ++k) {
                const bf16x8 af = *(const LAS bf16x8*)(lds + MS_BT + r * MS_ROW + (16 * k + 8 * hh) * 2), bfr = *(const LAS bf16x8*)(lds + MS_QT + r * MS_ROW + (16 * k + 8 * hh) * 2);
                const bf16x8 af2 = *(const LAS bf16x8*)(lds + MS_BT + r * MS_ROW + (16 * (k + 4) + 8 * hh) * 2), bfr2 = *(const LAS bf16x8*)(lds + MS_QT + r * MS_ROW + (16 * (k + 4) + 8 * hh) * 2);
                pt = MFMA32(af, bfr, pt); pt2 = MFMA32(af2, bfr2, pt2); }
#pragma unroll
            for (int i = 0; i < 16; ++i) { const int sk = (i & 3) + 8 * (i >> 2) + 4 * hh; pt[i] = (sk <= r) ? pt[i] + pt2[i] : 0.f; }
            if (BR == 1) {
#pragma unroll
                for (int g4 = 0; g4 < 4; ++g4) { const f32x4 iv = *(const LAS f32x4*)(IV + 8 * g4 + 4 * hh); den += pt[4 * g4] * iv.x + pt[4 * g4 + 1] * iv.y + pt[4 * g4 + 2] * iv.z + pt[4 * g4 + 3] * iv.w; }
#pragma unroll 2
                for (int k = 0; k < 8; ++k) { const u32x4 qw = *(const LAS u32x4*)(lds + MS_QT + r * MS_ROW + (64 * hh + 8 * k) * 2);
                    const f32x4 n0 = *(const LAS f32x4*)(NV + nvc + 64 * hh + 8 * k), n1 = *(const LAS f32x4*)(NV + nvc + 64 * hh + 8 * k + 4);
                    den += bflo(qw.x) * n0.x + bfhi(qw.x) * n0.y + bflo(qw.y) * n0.z + bfhi(qw.y) * n0.w + bflo(qw.z) * n1.x + bfhi(qw.z) * n1.y + bflo(qw.w) * n1.z + bfhi(qw.w) * n1.w; }
                den += __shfl_xor(den, 32);
            }
#pragma unroll
            for (int ks = 0; ks < 2; ++ks) { const bf16x8 vf = ld2x64(lds + MS_VT + (32 * wv + r) * MS_TROW + (16 * ks + 4 * hh) * 2); ot = MFMA32(vf, pack8(pt, ks), ot); }
        }
#pragma unroll
        for (int i = 0; i < 16; ++i) ot[i] += ot2[i];
#pragma unroll
        for (int dj = 0; dj < 2; ++dj) { const int db = 2 * dh + dj;
#pragma unroll
            for (int ks = 0; ks < 2; ++ks) { const bf16x8 af = *(const LAS bf16x8*)(lds + MS_BTT + (32 * db + r) * MS_TROW + (16 * ks + 8 * hh) * 2), vf = *(const LAS bf16x8*)(lds + MS_VT + (32 * wv + r) * MS_TROW + (16 * ks + 8 * hh) * 2);
                S[dj] = MFMA32(af, vf, S[dj]); }
#pragma unroll
            for (int g4 = 0; g4 < 4; ++g4) { const f32x4 al = *(const LAS f32x4*)(AL + 32 * db + 8 * g4 + 4 * hh);
                S[dj][4 * g4] *= al.x; S[dj][4 * g4 + 1] *= al.y; S[dj][4 * g4 + 2] *= al.z; S[dj][4 * g4 + 3] *= al.w; }
        }
        __builtin_amdgcn_s_setprio(0);
        if (BR == 1 && wave >= 6) {
            const int d = 64 * (wave - 6) + lane; float ns = 0.f;
#pragma unroll 2
            for (int k = 0; k < 4; ++k) { const u32x4 bw = *(const LAS u32x4*)(lds + MS_BTT + d * MS_TROW + 16 * k); const f32x4 i0 = *(const LAS f32x4*)(IV + 8 * k), i1 = *(const LAS f32x4*)(IV + 8 * k + 4);
                ns += bflo(bw.x) * i0.x + bfhi(bw.x) * i0.y + bflo(bw.y) * i0.z + bfhi(bw.y) * i0.w + bflo(bw.z) * i1.x + bfhi(bw.z) * i1.y + bflo(bw.w) * i1.z + bfhi(bw.w) * i1.w; }
            NV[nvn + d] = AL[d] * (NV[nvc + d] + ns);
        }
        if (dh == 1) {
#pragma unroll
            for (int g4 = 0; g4 < 4; ++g4) *(LAS f32x4*)(XO + ((wv * 4 + g4) * 64 + lane) * 4) = (f32x4){ot[4 * g4], ot[4 * g4 + 1], ot[4 * g4 + 2], ot[4 * g4 + 3]};
        }
        __builtin_amdgcn_sched_barrier(0);
#if SCAN_XBAR
        __syncthreads();
#endif
        part1(SETN);
        if (SCAN_DUP & 1) part1(SETN);
        __syncthreads();
        for (int orep = 0; orep < ((SCAN_DUP & 8) ? 2 : 1); ++orep)
        if (dh == 0) {
            const int t = ch * ML + r; const size_t mrow = (size_t)(b * TT + tok_of(t));
            const float sc = (BR == 1) ? 1.f / fmaxf(fabsf(den), 1.f) : 1.f;
            bf16_t* op = Ob + mrow * 1024 + 32 * wv + 4 * hh;
#pragma unroll
            for (int gp2 = 0; gp2 < 4; gp2 += 2) {
            f32x4 pov[2];
#pragma unroll
            for (int g4 = 0; g4 < 2; ++g4) pov[g4] = *(const LAS f32x4*)(XO + ((wv * 4 + gp2 + g4) * 64 + lane) * 4);
#pragma unroll
            for (int g4i = 0; g4i < 2; ++g4i) { const int g4 = gp2 + g4i; const f32x4 po = pov[g4i];
                u32x2 w;
                if (BR == 1) { w.x = pk2((ot[4 * g4] + po.x) * sc, (ot[4 * g4 + 1] + po.y) * sc); w.y = pk2((ot[4 * g4 + 2] + po.z) * sc, (ot[4 * g4 + 3] + po.w) * sc); }
                else { w.x = pk2(ot[4 * g4] + po.x, ot[4 * g4 + 1] + po.y); w.y = pk2(ot[4 * g4 + 2] + po.z, ot[4 * g4 + 3] + po.w); }
                st_b64_untracked(op + 8 * g4, w); }
            }
        }
#if SCAN_XBAR
        __syncthreads();
#endif
        part2(SETN);
        if (SCAN_DUP & 2) part2(SETN);
        __builtin_amdgcn_sched_barrier(0);
        issue(ch + 3, SETN);
        if (SCAN_DUP & 16) { asm volatile("" ::: "memory"); issue(ch + 3, SETN); }
        __syncthreads();
    };
    for (int ch = 0; ch < MNCH; ch += 2) { iter(ch, IC1); iter(ch + 1, IC0); }
}

constexpr int KS_ROWB = 272, VT_ROWB = 72, KS_BYTES = 32 * KS_ROWB, VT_BYTES = 128 * VT_ROWB, AT_BUF = KS_BYTES + VT_BYTES;
template <bool LAT>
__device__ __forceinline__ void attn_unit(const Params& p, int layer, int b, int qg, int kvh, LAS unsigned char* lds) {
    const int tid = opaque_tid(), lane = tid & 63, wave = __builtin_amdgcn_readfirstlane(tid >> 6), r = lane & 31, hh = lane >> 5;
    const bf16_t* P = (const bf16_t*)(p.ws + WS_P);
    bf16_t* Y = (bf16_t*)(p.ws + WS_A);
    const float* tab = (const float*)(p.ws + WS_ROPE);
    const int head = kvh * 4 + (wave >> 1), qpos = qg * 64 + (wave & 1) * 32 + r;
    const int mq = b * TT + (LAT ? CTXL + qpos : qpos);
    bf16x8 qf[8];
    {
        const bf16_t* qp = P + (size_t)mq * NP + C_CQ + head * 128 + 8 * hh;
        const float scl = 0.08838834764831845f;
#pragma unroll
        for (int g = 0; g < 4; ++g) {
            const int s0 = (g & 1) + 4 * (g >> 1);
            const u32x4 ra = *(const u32x4*)(qp + 16 * s0), rb = *(const u32x4*)(qp + 16 * (s0 + 2));
            float xa[8] = {bflo(ra.x), bfhi(ra.x), bflo(ra.y), bfhi(ra.y), bflo(ra.z), bfhi(ra.z), bflo(ra.w), bfhi(ra.w)};
            float xb[8] = {bflo(rb.x), bfhi(rb.x), bflo(rb.y), bfhi(rb.y), bflo(rb.z), bfhi(rb.z), bflo(rb.w), bfhi(rb.w)};
            float oa[8], ob[8];
            if (LAT) {
                const int pos = (g < 2) ? (qpos >> 6) : (qpos & 63); const int i0 = 16 * (g & 1) + 8 * hh;
                const f32x4* tp = (const f32x4*)(tab + (size_t)(pos * 32 + i0) * 2);
#pragma unroll
                for (int jj = 0; jj < 4; ++jj) { const f32x4 cs = tp[jj];
                    oa[2 * jj] = xa[2 * jj] * cs.x - xb[2 * jj] * cs.y; ob[2 * jj] = xb[2 * jj] * cs.x + xa[2 * jj] * cs.y;
                    oa[2 * jj + 1] = xa[2 * jj + 1] * cs.z - xb[2 * jj + 1] * cs.w; ob[2 * jj + 1] = xb[2 * jj + 1] * cs.z + xa[2 * jj + 1] * cs.w; }
            } else {
#pragma unroll
                for (int j = 0; j < 8; ++j) { oa[j] = xa[j]; ob[j] = xb[j]; }
            }
            u32x4 wa, wb;
            wa.x = pk2(oa[0] * scl, oa[1] * scl); wa.y = pk2(oa[2] * scl, oa[3] * scl); wa.z = pk2(oa[4] * scl, oa[5] * scl); wa.w = pk2(oa[6] * scl, oa[7] * scl);
            wb.x = pk2(ob[0] * scl, ob[1] * scl); wb.y = pk2(ob[2] * scl, ob[3] * scl); wb.z = pk2(ob[4] * scl, ob[5] * scl); wb.w = pk2(ob[6] * scl, ob[7] * scl);
            qf[s0] = __builtin_bit_cast(bf16x8, wa); qf[s0 + 2] = __builtin_bit_cast(bf16x8, wb);
        }
    }
    const int skey = tid >> 4, sc = tid & 15;
    constexpr int NLAT = LAT ? 10 : 0, NT = NLAT + 8;
    u32x4 kraw, kprt, vraw; int kpos = 0; bool krope = false;
    auto issue = [&](int j) {
        int row;
        if (j < NLAT) { const int s = qg * 64 - 128 + 32 * j + skey; const int scl = s < 0 ? 0 : (s > SEQ - 1 ? SEQ - 1 : s); row = b * TT + CTXL + scl; kpos = scl; krope = true; }
        else { row = b * TT + 32 * (j - NLAT) + skey; krope = false; }
        const bf16_t* pr = P + (size_t)row * NP;
        kraw = *(const u32x4*)(pr + C_CK + kvh * 128 + 8 * sc);
        kprt = *(const u32x4*)(pr + C_CK + kvh * 128 + 8 * (sc ^ 4));
        vraw = *(const u32x4*)(pr + C_CV + kvh * 128 + 8 * sc);
    };
    auto stage = [&](int buf) {
        LAS unsigned char* ks = lds + buf * AT_BUF; LAS unsigned char* vt = ks + KS_BYTES;
        u32x4 kw = kraw;
        if (LAT && krope) {
            const float x[8] = {bflo(kraw.x), bfhi(kraw.x), bflo(kraw.y), bfhi(kraw.y), bflo(kraw.z), bfhi(kraw.z), bflo(kraw.w), bfhi(kraw.w)};
            const float y[8] = {bflo(kprt.x), bfhi(kprt.x), bflo(kprt.y), bfhi(kprt.y), bflo(kprt.z), bfhi(kprt.z), bflo(kprt.w), bfhi(kprt.w)};
            const int pos = (sc < 8) ? (kpos >> 6) : (kpos & 63); const int i0 = (8 * sc) & 31; const float sg = (sc & 4) ? 1.f : -1.f;
            const f32x4* tp = (const f32x4*)(tab + (size_t)(pos * 32 + i0) * 2);
            float o[8];
#pragma unroll
            for (int jj = 0; jj < 4; ++jj) { const f32x4 cs = tp[jj]; o[2 * jj] = x[2 * jj] * cs.x + sg * y[2 * jj] * cs.y; o[2 * jj + 1] = x[2 * jj + 1] * cs.z + sg * y[2 * jj + 1] * cs.w; }
            kw.x = pk2(o[0], o[1]); kw.y = pk2(o[2], o[3]); kw.z = pk2(o[4], o[5]); kw.w = pk2(o[6], o[7]);
        }
        *(LAS u32x4*)(ks + skey * KS_ROWB + sc * 16) = kw;
        LAS unsigned short* vp = (LAS unsigned short*)(vt + (8 * sc) * VT_ROWB + skey * 2);
        vp[0 * (VT_ROWB / 2)] = (unsigned short)(vraw.x & 0xffffu); vp[1 * (VT_ROWB / 2)] = (unsigned short)(vraw.x >> 16);
        vp[2 * (VT_ROWB / 2)] = (unsigned short)(vraw.y & 0xffffu); vp[3 * (VT_ROWB / 2)] = (unsigned short)(vraw.y >> 16);
        vp[4 * (VT_ROWB / 2)] = (unsigned short)(vraw.z & 0xffffu); vp[5 * (VT_ROWB / 2)] = (unsigned short)(vraw.z >> 16);
        vp[6 * (VT_ROWB / 2)] = (unsigned short)(vraw.w & 0xffffu); vp[7 * (VT_ROWB / 2)] = (unsigned short)(vraw.w >> 16);
    };
    f32x16 O[4];
#pragma unroll
    for (int k = 0; k < 4; ++k)
#pragma unroll
        for (int i = 0; i < 16; ++i) O[k][i] = 0.f;
    float mrun = p.in[12][layer * 8 + head], lrun = 1.f;
    __syncthreads();
    issue(0); stage(0);
    __syncthreads();
    for (int j = 0; j < NT; ++j) {
        const int buf = j & 1;
        if (j + 1 < NT) issue(j + 1);
        const LAS unsigned char* ks = lds + buf * AT_BUF; const LAS unsigned char* vt = ks + KS_BYTES;
        const int s0t = qg * 64 - 128 + 32 * j, rel = -128 + 32 * j - 32 * (wave & 1);
        const bool islat = LAT && j < NLAT;
        const bool skipt = islat && (rel <= -160 || rel >= 160 || s0t + 31 < 0 || s0t >= SEQ);
        const bool needmask = islat && !(rel >= -96 && rel <= 96 && s0t >= 0 && s0t + 31 < SEQ);
        if (!skipt) {
        f32x16 sa;
#pragma unroll
        for (int i = 0; i < 16; ++i) sa[i] = 0.f;
#pragma unroll
        for (int s = 0; s < 8; ++s) { const bf16x8 kf = *(const LAS bf16x8*)(ks + r * KS_ROWB + (16 * s + 8 * hh) * 2); sa = MFMA32(kf, qf[s], sa); }
        if (needmask) {
            const int s0 = qg * 64 - 128 + 32 * j + 4 * hh;
#pragma unroll
            for (int i = 0; i < 16; ++i) { const int sk = s0 + (i & 3) + 8 * (i >> 2); const int dd = qpos - sk; const bool ok = ((unsigned)sk < (unsigned)SEQ) && (dd <= 128) && (dd >= -128); sa[i] = ok ? sa[i] : -1e30f; }
        }
        float mx = sa[0];
#pragma unroll
        for (int i = 1; i < 16; ++i) mx = fmaxf(mx, sa[i]);
        mx = fmaxf(mx, __shfl_xor(mx, 32));
        const float mnew = fmaxf(mrun, mx), alpha = __expf(mrun - mnew);
        float ps = 0.f; float pv[16];
#pragma unroll
        for (int i = 0; i < 16; ++i) { pv[i] = __expf(sa[i] - mnew); ps += pv[i]; }
        ps += __shfl_xor(ps, 32);
        lrun = lrun * alpha + ps; mrun = mnew;
#pragma unroll
        for (int k = 0; k < 4; ++k)
#pragma unroll
            for (int i = 0; i < 16; ++i) O[k][i] *= alpha;
#pragma unroll
        for (int s = 0; s < 2; ++s) {
            u32x4 pw; pw.x = pk2(pv[8 * s], pv[8 * s + 1]); pw.y = pk2(pv[8 * s + 2], pv[8 * s + 3]); pw.z = pk2(pv[8 * s + 4], pv[8 * s + 5]); pw.w = pk2(pv[8 * s + 6], pv[8 * s + 7]);
            const bf16x8 pf = __builtin_bit_cast(bf16x8, pw);
#pragma unroll
            for (int k = 0; k < 4; ++k) {
                const LAS unsigned char* vr = vt + (32 * k + r) * VT_ROWB + (16 * s + 4 * hh) * 2;
                const u32x2 lo = *(const LAS u32x2*)(vr), hi = *(const LAS u32x2*)(vr + 16);
                u32x4 vw; vw.x = lo.x; vw.y = lo.y; vw.z = hi.x; vw.w = hi.y;
                O[k] = MFMA32(__builtin_bit_cast(bf16x8, vw), pf, O[k]);
            }
        }
        }
        if (j + 1 < NT) stage(buf ^ 1);
        __syncthreads();
    }
    const float inv = 1.f / lrun;
    const bf16_t* zp = P + (size_t)mq * NP + C_CZ + head * 128 + 4 * hh;
    bf16_t* yp = (bf16_t*)(p.ws + WS_P) + (size_t)mq * NP + C_CQ + head * 128 + 4 * hh;
    u32x2 zr[4][4];
#pragma unroll
    for (int k = 0; k < 4; ++k)
#pragma unroll
        for (int g = 0; g < 4; ++g) zr[k][g] = *(const u32x2*)(zp + 32 * k + 8 * g);
#pragma unroll
    for (int k = 0; k < 4; ++k)
#pragma unroll
        for (int g = 0; g < 4; ++g) {
            const u32x2 z = zr[k][g];
            const float o0 = O[k][4 * g] * inv * siluf(bflo(z.x)), o1 = O[k][4 * g + 1] * inv * siluf(bfhi(z.x)), o2 = O[k][4 * g + 2] * inv * siluf(bflo(z.y)), o3 = O[k][4 * g + 3] * inv * siluf(bfhi(z.y));
            u32x2 w; w.x = pk2(o0, o1); w.y = pk2(o2, o3);
            *(u32x2*)(yp + 32 * k + 8 * g) = w;
        }
}

__device__ __forceinline__ void mixer_phase(const Params& p, int layer, LAS unsigned char* lds) {
    const int G = (int)gridDim.x, bid = (int)blockIdx.x;
    const int nunits = 512 + (layer == 0 ? 32 : 0);
#if USE_VALU_SCAN == 1
    for (int u = bid; u < 256; u += G) { if (u < 128) scan_unit<0>(p, layer, u, lds); else scan_unit<1>(p, layer, u, lds); }
    const int a0 = bid, astep = G;
#elif USE_VALU_SCAN == 2
    if (bid < 32) scan_mfma<0>(p, layer, bid, lds); else if (bid < 160) scan_unit<1>(p, layer, 128 + bid - 32, lds);
    const int a0 = bid, astep = G;
#elif USE_VALU_SCAN == 3
    if (bid < 32) scan_mfma<1>(p, layer, 32 + bid, lds); else if (bid < 160) scan_unit<0>(p, layer, bid - 32, lds);
    const int a0 = bid, astep = G;
#else
    const bool split = G > 2 * SCAN_WGS;
    for (int rep = 0; rep < ((MIX_DUP & 3) ? 2 : 1); ++rep)
    for (int u = bid; u < 64; u += (split ? 64 : G)) { if (u < 32) { if (MIX_MASK & 1) scan_mfma<0>(p, layer, u, lds); } else { if (MIX_MASK & 2) scan_mfma<1>(p, layer, u, lds); } }
    if (split && bid >= SCAN_WGS) {
        const int na = G - SCAN_WGS;
        pg8::Gemm g{(const bf16_t*)(p.ws + WS_A), (const bf16_t*)(p.ws + WS_WIN) + (size_t)layer * NP * D + (size_t)NX * D, MROWS, NY1, D};
        pg8::StaticOrder S; S.init(MROWS, NY1, na, bid - SCAN_WGS);
        pg8::EpiP E{(bf16_t*)(p.ws + WS_P) + NX, NP};
        pg8::gemm_phase<pg8::EpiP, pg8::StaticOrder, true, true>(lds, g, S, E);
        unsigned* cnt = (unsigned*)(p.ws + WS_BAR) + layer * 64;
        asm volatile("s_waitcnt vmcnt(0)" ::: "memory");
        __syncthreads();
        if (threadIdx.x == 0) {
            __builtin_amdgcn_fence(__ATOMIC_RELEASE, "agent");
            asm volatile("s_waitcnt vmcnt(0)" ::: "memory");
            __hip_atomic_fetch_add(cnt, 1u, __ATOMIC_RELAXED, __HIP_MEMORY_SCOPE_AGENT);
            unsigned spins = 0;
            while (__hip_atomic_load(cnt, __ATOMIC_RELAXED, __HIP_MEMORY_SCOPE_AGENT) < (unsigned)na) { __builtin_amdgcn_s_sleep(2); if (++spins > (1u << 24)) break; }
            __builtin_amdgcn_fence(__ATOMIC_ACQUIRE, "agent");
            asm volatile("s_waitcnt vmcnt(0)" ::: "memory");
        }
        __syncthreads();
    }
    const int a0 = split ? (bid < SCAN_WGS ? nunits : bid - SCAN_WGS) : bid, astep = split ? G - SCAN_WGS : G;
#endif
    for (int rep = 0; rep < ((MIX_DUP & 4) ? 2 : 1); ++rep)
    if (MIX_MASK & 4) for (int u = a0; u < nunits; u += astep) {
        if (u < 512) attn_unit<true>(p, layer, u >> 7, (u & 127) >> 1, u & 1, lds);
        else { const int v = u - 512; attn_unit<false>(p, layer, (v >> 3) & 3, (v >> 1) & 3, v & 1, lds); }
    }
#if USE_VALU_SCAN == 0
    if (layer == 0 && split && bid >= SCAN_WGS) { __syncthreads(); weight_transposes(p, lds, 1, (bid - SCAN_WGS) * 8 + ((int)threadIdx.x >> 6), (G - SCAN_WGS) * 8); }
#endif
}

__device__ __forceinline__ void readout_phase(const Params& p, int layer) {
    const int tid = opaque_tid(), lane = tid & 63, wave = tid >> 6;
    const int gw = blockIdx.x * 8 + wave, NGW = gridDim.x * 8;
    const bf16_t* P = (const bf16_t*)(p.ws + WS_P);
    const bf16_t* Of = (const bf16_t*)(p.ws + WS_O); const bf16_t* Obk = Of + (size_t)MROWS * 1024;
    bf16_t* Y = (bf16_t*)(p.ws + WS_A);
    const int ch0 = lane * 16; const bool isb = lane >= 32;
    for (int m0 = gw; m0 < MROWS; m0 += 2 * NGW) {
        int mm[2]; bool act[2];
        u32x4 fr[2][2], br[2][2], gr[2][2], orr[2][2], cr[2][2];
#pragma unroll
        for (int q = 0; q < 2; ++q) {
            const int mq_ = m0 + q * NGW; const int m = mq_ < MROWS ? mq_ : MROWS - 1; mm[q] = m;
            act[q] = (mq_ < MROWS) && !(layer == 1 && (m % TT) < CTXL);
            fr[q][0] = *(const u32x4*)(Of + (size_t)m * 1024 + ch0); fr[q][1] = *(const u32x4*)(Of + (size_t)m * 1024 + ch0 + 8);
            br[q][0] = *(const u32x4*)(Obk + (size_t)m * 1024 + ch0); br[q][1] = *(const u32x4*)(Obk + (size_t)m * 1024 + ch0 + 8);
            const bf16_t* gp = P + (size_t)m * NP + (isb ? C_BZ + ch0 - 512 : C_AG + ch0);
            gr[q][0] = *(const u32x4*)(gp); gr[q][1] = *(const u32x4*)(gp + 8);
            const bf16_t* op = P + (size_t)m * NP + C_BO + (isb ? ch0 - 512 : ch0);
            orr[q][0] = *(const u32x4*)(op); orr[q][1] = *(const u32x4*)(op + 8);
            const bf16_t* cp = P + (size_t)m * NP + C_CQ + ch0;
            cr[q][0] = *(const u32x4*)(cp); cr[q][1] = *(const u32x4*)(cp + 8);
        }
#pragma unroll
        for (int q = 0; q < 2; ++q) {
            if (!act[q]) continue;
            const int m = mm[q];
            float y[16], g[16];
            const unsigned fw[8] = {fr[q][0].x, fr[q][0].y, fr[q][0].z, fr[q][0].w, fr[q][1].x, fr[q][1].y, fr[q][1].z, fr[q][1].w};
            const unsigned bw[8] = {br[q][0].x, br[q][0].y, br[q][0].z, br[q][0].w, br[q][1].x, br[q][1].y, br[q][1].z, br[q][1].w};
            const unsigned gw8[8] = {gr[q][0].x, gr[q][0].y, gr[q][0].z, gr[q][0].w, gr[q][1].x, gr[q][1].y, gr[q][1].z, gr[q][1].w};
#pragma unroll
            for (int e = 0; e < 8; ++e) { y[2 * e] = bflo(fw[e]) + bflo(bw[e]); y[2 * e + 1] = bfhi(fw[e]) + bfhi(bw[e]); g[2 * e] = bflo(gw8[e]); g[2 * e + 1] = bfhi(gw8[e]); }
            if (isb) {
                const unsigned ow[8] = {orr[q][0].x, orr[q][0].y, orr[q][0].z, orr[q][0].w, orr[q][1].x, orr[q][1].y, orr[q][1].z, orr[q][1].w};
#pragma unroll
                for (int e = 0; e < 8; ++e) { y[2 * e] *= sigm(bflo(ow[e])); y[2 * e + 1] *= sigm(bfhi(ow[e])); }
            }
            float ss = 0.f;
#pragma unroll
            for (int e = 0; e < 16; ++e) ss += y[e] * y[e];
            ss += __shfl_xor(ss, 1); ss += __shfl_xor(ss, 2); ss += __shfl_xor(ss, 4);
            const float rs = __builtin_amdgcn_rsqf(ss * (1.f / 128.f) + EPS);
            u32x4 w0, w1; unsigned ww[8];
#pragma unroll
            for (int e = 0; e < 8; ++e) ww[e] = pk2(y[2 * e] * rs * siluf(g[2 * e]), y[2 * e + 1] * rs * siluf(g[2 * e + 1]));
            w0.x = ww[0]; w0.y = ww[1]; w0.z = ww[2]; w0.w = ww[3]; w1.x = ww[4]; w1.y = ww[5]; w1.z = ww[6]; w1.w = ww[7];
            *(u32x4*)(Y + (size_t)m * D + ch0) = w0; *(u32x4*)(Y + (size_t)m * D + ch0 + 8) = w1;
            *(u32x4*)(Y + (size_t)m * D + 1024 + ch0) = cr[q][0]; *(u32x4*)(Y + (size_t)m * D + 1024 + ch0 + 8) = cr[q][1];
        }
    }
}

#define XB_TMO      128
#define XB_XCNT(j)  (256  + 64 * (j))
#define XB_XSUB(j)  (1280 + 64 * (j))
#define XB_XGEN(j)  (2304 + 64 * (j))
#define XB_TOP      3328
#define XB_TOPGEN   3392
#define XCD_BAR_WORDS 3456
#define XB_SPIN_CAP (1u << 18)

__device__ __forceinline__ unsigned xb_ld(unsigned* p)              { return __hip_atomic_load(p, __ATOMIC_RELAXED, __HIP_MEMORY_SCOPE_AGENT); }
__device__ __forceinline__ unsigned xb_add(unsigned* p, unsigned v) { return __hip_atomic_fetch_add(p, v, __ATOMIC_RELAXED, __HIP_MEMORY_SCOPE_AGENT); }
__device__ __forceinline__ unsigned xb_xcc_id() { return (unsigned)__builtin_amdgcn_s_getreg((3 << 11) | 20) & 0xFu; }
#define XB_SPIN(cond, bar) do { unsigned _sp = 0; while (cond) { __builtin_amdgcn_s_sleep(1); \
    if ((++_sp & 255u) == 0u) { if (xb_ld(&(bar)[XB_TMO])) break; if (_sp > XB_SPIN_CAP) { atomicAdd(&(bar)[XB_TMO], 1u); break; } } } } while (0)

struct XcdBarrier {
    unsigned* bar; unsigned x;
    volatile LAS unsigned* st;
};

__device__ __forceinline__ XcdBarrier xcd_barrier_post(unsigned* bar, volatile LAS unsigned* st) {
    XcdBarrier b; b.bar = bar; b.x = xb_xcc_id(); b.st = st;
    if (threadIdx.x == 0) (void)xb_add(&bar[XB_XCNT(b.x)], 1u);
    return b;
}
__device__ __forceinline__ void xcd_barrier_complete(unsigned* bar, unsigned x, unsigned& nloc, unsigned& nx) {
    const unsigned G = gridDim.x * gridDim.y * gridDim.z;
    unsigned sum, cnt, mine, sp = 0u;
    for (;;) {
        sum = 0u; cnt = 0u; mine = 0u;
#pragma unroll
        for (unsigned j = 0; j < 16; ++j) { const unsigned c = xb_ld(&bar[XB_XCNT(j)]); sum += c; cnt += (c > 0u) ? 1u : 0u; mine = (j == x) ? c : mine; }
        if (sum == G) break;
        __builtin_amdgcn_s_sleep(1);
        if ((++sp & 255u) == 0u) { if (xb_ld(&bar[XB_TMO])) break; if (sp > XB_SPIN_CAP) { atomicAdd(&bar[XB_TMO], 1u); break; } }
    }
    nloc = mine > 0u ? mine : 1u; nx = cnt > 0u ? cnt : 1u;
}

__device__ __forceinline__ void xcd_barrier(const XcdBarrier& b) {
    asm volatile("s_waitcnt vmcnt(0)" ::: "memory");
    __syncthreads();
    if (threadIdx.x == 0) {
        unsigned* bar = b.bar;
        __builtin_amdgcn_s_waitcnt(0);
        unsigned nloc = b.st[0], nx = b.st[1];
        if (nloc == 0u) { xcd_barrier_complete(bar, b.x, nloc, nx); b.st[0] = nloc; b.st[1] = nx; }
        const unsigned old = xb_add(&bar[XB_XSUB(b.x)], 1u);
        const unsigned gen = old / nloc;
        if (old + 1u == (gen + 1u) * nloc) {
            __builtin_amdgcn_fence(__ATOMIC_RELEASE, "agent");
            asm volatile("s_waitcnt vmcnt(0)" ::: "memory");
            const unsigned og = xb_add(&bar[XB_TOP], 1u);
            const unsigned tg = og / nx;
            if (og + 1u == (tg + 1u) * nx) xb_add(&bar[XB_TOPGEN], 1u);
            else XB_SPIN(xb_ld(&bar[XB_TOPGEN]) == tg, bar);
            __builtin_amdgcn_fence(__ATOMIC_ACQUIRE, "agent");
            xb_add(&bar[XB_XGEN(b.x)], 1u);
            asm volatile("s_waitcnt vmcnt(0)" ::: "memory");
        } else {
            XB_SPIN(xb_ld(&bar[XB_XGEN(b.x)]) == gen, bar);
            __builtin_amdgcn_fence(__ATOMIC_ACQUIRE, "agent");
            asm volatile("s_waitcnt vmcnt(0)" ::: "memory");
        }
    }
    __syncthreads();
}

__global__ void __launch_bounds__(512, 2) mega_fwd(Params p) {
    extern __shared__ __attribute__((aligned(16))) unsigned char lds_raw[];
    LAS unsigned char* lds = (LAS unsigned char*)lds_raw;
    cg::grid_group grid = cg::this_grid();
    volatile LAS unsigned* xst = (volatile LAS unsigned*)(lds + 131072);
    if (threadIdx.x < 2) xst[threadIdx.x] = 0u;
    __syncthreads();
    XcdBarrier xbar = xcd_barrier_post((unsigned*)(p.ws + WS_XBAR), xst);
    for (int ph = p.ph_lo; ph < p.ph_hi; ++ph) {
        int nrep = 1;
        if (DUP_MASK != 0 && ph >= 2 && ((DUP_MASK >> ((ph - 2) % 5)) & 1)) nrep = 2;
        for (int rep = 0; rep < nrep; ++rep) {
        if (ph == 0) { if (PH_MASK & 1) p0_prologue(p, lds); }
        else if (ph == 1) { if (PH_MASK & 2) row_phase<0>(p); }
        else {
            const int layer = (ph - 2) / 5, sub = (ph - 2) % 5;
            if (sub == 0) { if (PH_MASK & 4) {
                const int nfirst = ((int)gridDim.x > 2 * SCAN_WGS) ? NX : NP;
                pg8::Gemm g{(const bf16_t*)(p.ws + WS_A), (const bf16_t*)(p.ws + WS_WIN) + (size_t)layer * NP * D, MROWS, nfirst, D};
                pg8::StaticOrder S; S.init(MROWS, nfirst, (int)gridDim.x, (int)blockIdx.x);
                pg8::EpiP E{(bf16_t*)(p.ws + WS_P), NP};
                pg8::gemm_phase<pg8::EpiP, pg8::StaticOrder, true, true>(lds, g, S, E); }
            } else if (sub == 1) { if (PH_MASK & 8) mixer_phase(p, layer, lds); }
            else if (sub == 2) { if (PH_MASK & 16) readout_phase(p, layer); }
            else if (sub == 3) { if (PH_MASK & 32) {
                pg8::Gemm g{(const bf16_t*)(p.ws + WS_A), (const bf16_t*)(p.ws + WS_WOUT) + (size_t)layer * D * D, MROWS, D, D};
                pg8::EpiP E{(bf16_t*)(p.ws + WS_P), D};
                if (layer == 0) { pg8::StaticOrder S; S.init(MROWS, D, (int)gridDim.x, (int)blockIdx.x); pg8::gemm_phase<pg8::EpiP, pg8::StaticOrder, true, true>(lds, g, S, E); }
                else { pg8::LatentOrder S; S.init(NBATCH * SEQ, D, (int)gridDim.x, (int)blockIdx.x); pg8::gemm_phase<pg8::EpiP, pg8::LatentOrder, true, true>(lds, g, S, E); } }
            } else { if (PH_MASK & 64) { if (layer == 0) row_phase<1>(p); else row_phase<2>(p); } }
        }
        }
        if (ph + 1 < p.ph_hi) { if (p.ph_hi > NPHASE) grid.sync(); else xcd_barrier(xbar); }
    }
}

#ifndef MK_PER_PHASE
#define MK_PER_PHASE 0
#endif
extern "C" void kernel_launch(void* const* d_in, const int* in_sizes, int n_in, void* d_out, int out_size, void* d_ws, size_t ws_size, hipStream_t stream) {
    static int grid = 0;
    if (grid == 0) {
        if (n_in != 14 || ws_size < WS_END) { fprintf(stderr, "kernel_launch: unexpected inputs (n_in %d, ws %zu < %zu)\n", n_in, ws_size, (size_t)WS_END); grid = -1; return; }
        int dev = 0, cus = 0, per_cu = 0;
        hipGetDevice(&dev); hipDeviceGetAttribute(&cus, hipDeviceAttributeMultiprocessorCount, dev);
        if (hipFuncSetAttribute((const void*)mega_fwd, hipFuncAttributeMaxDynamicSharedMemorySize, LDS_BYTES) != hipSuccess) { fprintf(stderr, "kernel_launch: hipFuncSetAttribute failed\n"); grid = -1; return; }
        if (hipOccupancyMaxActiveBlocksPerMultiprocessor(&per_cu, (const void*)mega_fwd, 512, LDS_BYTES) != hipSuccess || per_cu < 1) { fprintf(stderr, "kernel_launch: occupancy query says %d\n", per_cu); per_cu = 1; }
        (void)hipGetLastError();
        grid = cus * (per_cu > 1 ? 1 : per_cu);
        if (grid > 256) grid = 256;
    }
    if (grid < 0) return;
    (void)hipMemsetAsync((char*)d_ws + WS_MOD, 0, (size_t)2 * 5 * NMOD * 4 + 1024 + 16384, stream);
    Params p{};
    for (int i = 0; i < 14; ++i) p.in[i] = (const float*)d_in[i];
    p.out = (float*)d_out; p.ws = (unsigned char*)d_ws;
#if MK_PER_PHASE
    for (int ph = 0; ph < NPHASE; ++ph) { p.ph_lo = ph; p.ph_hi = ph + 1; hipLaunchKernelGGL(mega_fwd, dim3(grid), dim3(512), LDS_BYTES, stream, p); }
#else
    p.ph_lo = 0; p.ph_hi = NPHASE;
    void* args[] = {&p};
    hipError_t e = hipLaunchCooperativeKernel((const void*)mega_fwd, dim3(grid), dim3(512), args, LDS_BYTES, stream);
    if (e != hipSuccess) fprintf(stderr, "cooperative launch failed: %s (grid %d)\n", hipGetErrorString(e), grid);
#endif
}
```

```cpp
#include <hip/hip_runtime.h>
#include <hip/hip_cooperative_groups.h>
#include <cstdio>
#include <cstdint>
#include <type_traits>
namespace cg = cooperative_groups;
__device__ __forceinline__ int opaque_tid() { int t = threadIdx.x; asm volatile("" : "+v"(t)); return t; }
__device__ __forceinline__ int opaque_bid() { int t = blockIdx.x; asm volatile("" : "+s"(t)); return t; }
#define MK_PER_PHASE 0
namespace pg8 {
#define PG8_LAS __attribute__((address_space(3)))
typedef unsigned short bf16_t;
typedef short bf16x8 __attribute__((ext_vector_type(8)));
typedef float f32x4 __attribute__((ext_vector_type(4)));
typedef unsigned u32x4 __attribute__((ext_vector_type(4)));
constexpr int BM = 256, BK = 64, HALF = 128, HTB = HALF * BK * 2  , STAGE_BYTES = 8 * HTB, NXCD = 8, WGM = 8;

__host__ __device__ __forceinline__ int lds_byte(int r, int c) { const int st = (r >> 4) * 2 + (c >> 5), rr = r & 15, cc = c & 31, ob = rr * 64 + cc * 2; return st * 1024 + (ob ^ (((ob >> 9) & 1) << 5)); }
__host__ __device__ __forceinline__ void stage_rc(int b, int& R, int& C) { const int st = b / 1024, sb = b % 1024, swz = sb ^ (((sb >> 9) & 1) << 5); R = (st >> 1) * 16 + swz / 64; C = (st & 1) * 32 + (swz % 64) / 2; }
__host__ __device__ __forceinline__ int perm32(int rho) { const int n = rho >> 4, i = rho & 15; return 8 * (i >> 2) + 4 * n + (i & 3); }

struct Unit { int pm, pn; };
struct Gemm { const bf16_t* A; const bf16_t* Bt; int M, N, K; };

struct StaticOrder {
    int nM, nN, nwg, G, c;
    __host__ __device__ void init(int M, int N, int G_, int c_) { nM = M / BM; nN = N / BM; nwg = nM * nN; G = G_; c = c_; }
    __host__ __device__ bool next(int i, Unit& u) const {
        const long L = (long)i * G + c; if (L >= nwg) return false;
        int wgid = (int)L; { const int q = nwg / NXCD, r = nwg % NXCD, xcd = wgid % NXCD, off = wgid / NXCD; wgid = (xcd < r ? xcd * (q + 1) : r * (q + 1) + (xcd - r) * q) + off; }
        const int nig = WGM * nN, gid = wgid / nig, fm = gid * WGM, gsz = (nM - fm) < WGM ? (nM - fm) : WGM;
        u.pm = fm + ((wgid % nig) % gsz); u.pn = (wgid % nig) / gsz; return true;
    }
    __device__ __forceinline__ void a_ready(const Unit&) const {}
    __device__ __forceinline__ void done(const Unit&) const {}
};

__device__ __forceinline__ unsigned cvt_pk_bf16(float lo, float hi) { unsigned r; asm volatile("v_cvt_pk_bf16_f32 %0, %1, %2" : "=v"(r) : "v"(lo), "v"(hi)); return r; }
typedef float f32x2 __attribute__((ext_vector_type(2)));
template <class Epi, class Sched, bool ALIGN_EPI = false, bool SP2 = false>
__device__ __forceinline__ void gemm_phase(PG8_LAS unsigned char* lds, const Gemm g, const Sched& S, const Epi& E) {
    const int tid = opaque_tid(), wid = __builtin_amdgcn_readfirstlane(tid >> 6), lane = tid & 63, wr = wid >> 2, wc = wid & 3, fr = lane & 15, fq = lane >> 4;
    const int K = g.K, nt = K / BK;
    unsigned voffA[2], voffB[2];
#pragma unroll
    for (int i = 0; i < 2; ++i) { int R, C; stage_rc(tid * 16 + i * 8192, R, C); const int Rb = Epi::PERM ? ((R & ~31) + perm32(R & 31)) : R;
        voffA[i] = (unsigned)(R * K + C) * 2u; voffB[i] = (unsigned)(Rb * K + C) * 2u; }
    const size_t kstep = (size_t)(BK * 2);
    const size_t hstep = (size_t)HALF * K * 2;
    const size_t tstep = 2 * hstep;
    const unsigned ldsw = (unsigned)wid * 1024u;
    const int aoff = lds_byte(wr * 64 + fr, fq * 8), boff = lds_byte(wc * 32 + fr, fq * 8);
#define PG8_SA(b, h) (((b) * 2 + (h)) * HTB)
#define PG8_SB(b, h) ((4 + (b) * 2 + (h)) * HTB)
#define PG8_STAGE(bufoff, gbase, voff) do { _Pragma("unroll") for (int _i = 0; _i < 2; ++_i) \
        __builtin_amdgcn_global_load_lds((const unsigned*)((const char*)(gbase) + (voff)[_i]), (PG8_LAS unsigned*)(lds + (bufoff) + ldsw + _i * 8192), 16, 0, 0); } while (0)
#define PG8_LDA(dst, b, h) do { _Pragma("unroll") for (int m = 0; m < 4; ++m) _Pragma("unroll") for (int k = 0; k < 2; ++k) dst[m][k] = *(const PG8_LAS bf16x8*)(lds + PG8_SA(b, h) + aoff + m * 2048 + k * 1024); } while (0)
#define PG8_LDB(dst, b, h) do { _Pragma("unroll") for (int n = 0; n < 2; ++n) _Pragma("unroll") for (int k = 0; k < 2; ++k) dst[n][k] = *(const PG8_LAS bf16x8*)(lds + PG8_SB(b, h) + boff + n * 2048 + k * 1024); } while (0)
#define PG8_MMA(ai, bj, At, Bt) do { __builtin_amdgcn_s_setprio(1); _Pragma("unroll") for (int m = 0; m < 4; ++m) _Pragma("unroll") for (int n = 0; n < 2; ++n) _Pragma("unroll") for (int k = 0; k < 2; ++k) \
        acc[ai][bj][m][n] = __builtin_amdgcn_mfma_f32_16x16x32_bf16(Bt[n][k], At[m][k], acc[ai][bj][m][n], 0, 0, 0); __builtin_amdgcn_s_setprio(0); } while (0)
#define PG8_WAIT_V(n) asm volatile("s_waitcnt vmcnt(" #n ")" ::: "memory")
#define PG8_WAIT_L(n) asm volatile("s_waitcnt lgkmcnt(" #n ")" ::: "memory")
#define PG8_BAR __builtin_amdgcn_s_barrier()
#define PG8_SCHED __builtin_amdgcn_sched_barrier(0)
    Unit cur, nxt; int ui = 0;
    if (!S.next(0, cur)) return;
    f32x4 acc[2][2][4][2];
#pragma unroll
    for (int a = 0; a < 2; ++a)
#pragma unroll
        for (int b = 0; b < 2; ++b)
#pragma unroll
            for (int m = 0; m < 4; ++m)
#pragma unroll
                for (int n = 0; n < 2; ++n) acc[a][b][m][n] = (f32x4){0.f, 0.f, 0.f, 0.f};
    bf16x8 At[4][2], B0[2][2], B1[2][2];
    const char* cA = (const char*)g.A + (size_t)cur.pm * tstep; const char* cB = (const char*)g.Bt + (size_t)cur.pn * tstep;
    S.a_ready(cur);
    if constexpr (SP2) {
        PG8_STAGE(PG8_SB(0, 0), cB, voffB); PG8_STAGE(PG8_SB(0, 1), cB + hstep, voffB); PG8_STAGE(PG8_SA(0, 0), cA, voffA); PG8_STAGE(PG8_SA(0, 1), cA + hstep, voffA);
        if (wr == 1) PG8_BAR;
        PG8_WAIT_V(2); PG8_BAR;
        PG8_STAGE(PG8_SB(1, 0), cB + kstep, voffB); PG8_STAGE(PG8_SA(1, 0), cA + kstep, voffA); PG8_STAGE(PG8_SB(1, 1), cB + hstep + kstep, voffB);
        PG8_WAIT_V(6); PG8_BAR;
    } else {
        PG8_STAGE(PG8_SB(0, 0), cB, voffB); PG8_STAGE(PG8_SA(0, 0), cA, voffA); PG8_STAGE(PG8_SB(0, 1), cB + hstep, voffB); PG8_STAGE(PG8_SA(0, 1), cA + hstep, voffA);
        if (wr == 1) PG8_BAR;
        PG8_WAIT_V(4); PG8_BAR;
        PG8_STAGE(PG8_SB(1, 0), cB + kstep, voffB); PG8_STAGE(PG8_SA(1, 0), cA + kstep, voffA); PG8_STAGE(PG8_SB(1, 1), cB + hstep + kstep, voffB);
        PG8_WAIT_V(6); PG8_BAR;
    }
    for (;;) {
        const bool has_next = S.next(ui + 1, nxt);
        const char* nA = has_next ? (const char*)g.A + (size_t)nxt.pm * tstep : cA; const char* nB = has_next ? (const char*)g.Bt + (size_t)nxt.pn * tstep : cB;
        for (int t = 0; t < nt; t += 2) {
            const bool last = (t == nt - 2);
            const char* a1 = cA + (size_t)(t + 1) * kstep;
            const char* a2 = last ? nA : cA + (size_t)(t + 2) * kstep; const char* b2 = last ? nB : cB + (size_t)(t + 2) * kstep;
            const char* a3 = a2 + kstep; const char* b3 = b2 + kstep;
            if (last && has_next) S.a_ready(nxt);
            if constexpr (SP2) {
            PG8_LDB(B0, 0, 0); PG8_LDB(B1, 0, 1); PG8_SCHED; PG8_LDA(At, 0, 0); PG8_STAGE(PG8_SA(1, 1), a1 + hstep, voffA);
            PG8_WAIT_V(8); PG8_WAIT_L(0); PG8_BAR; PG8_MMA(0, 0, At, B0); PG8_MMA(0, 1, At, B1); PG8_BAR; PG8_SCHED;
            PG8_LDA(At, 0, 1); PG8_STAGE(PG8_SB(0, 0), b2, voffB); PG8_STAGE(PG8_SB(0, 1), b2 + hstep, voffB); PG8_STAGE(PG8_SA(0, 0), a2, voffA);
            PG8_WAIT_V(8); PG8_WAIT_L(0); PG8_BAR; PG8_MMA(1, 0, At, B0); PG8_MMA(1, 1, At, B1); PG8_BAR; PG8_SCHED;
            PG8_LDB(B0, 1, 0); PG8_LDB(B1, 1, 1); PG8_SCHED; PG8_LDA(At, 1, 0); PG8_STAGE(PG8_SA(0, 1), a2 + hstep, voffA);
            PG8_WAIT_V(8); PG8_WAIT_L(0); PG8_BAR; PG8_MMA(0, 0, At, B0); PG8_MMA(0, 1, At, B1); PG8_BAR; PG8_SCHED;
            PG8_LDA(At, 1, 1); PG8_STAGE(PG8_SB(1, 0), b3, voffB); PG8_STAGE(PG8_SB(1, 1), b3 + hstep, voffB); PG8_STAGE(PG8_SA(1, 0), a3, voffA);
            PG8_WAIT_V(8); PG8_WAIT_L(0); PG8_BAR; PG8_MMA(1, 0, At, B0); PG8_MMA(1, 1, At, B1); PG8_BAR; PG8_SCHED;
            } else {
            PG8_LDB(B0, 0, 0); PG8_SCHED; PG8_LDA(At, 0, 0); PG8_STAGE(PG8_SA(1, 1), a1 + hstep, voffA);
            PG8_WAIT_L(8); PG8_BAR; PG8_WAIT_L(0); PG8_MMA(0, 0, At, B0); PG8_BAR; PG8_SCHED;
            PG8_LDB(B1, 0, 1); PG8_STAGE(PG8_SB(0, 0), b2, voffB);
            PG8_BAR; PG8_WAIT_L(0); PG8_MMA(0, 1, At, B1); PG8_BAR;
            PG8_LDA(At, 0, 1); PG8_STAGE(PG8_SA(0, 0), a2, voffA);
            PG8_BAR; PG8_WAIT_L(0); PG8_MMA(1, 0, At, B0); PG8_BAR; PG8_SCHED;
            PG8_STAGE(PG8_SB(0, 1), b2 + hstep, voffB);
            PG8_WAIT_V(6); PG8_BAR; PG8_MMA(1, 1, At, B1); PG8_BAR;
            PG8_LDB(B0, 1, 0); PG8_SCHED; PG8_LDA(At, 1, 0); PG8_STAGE(PG8_SA(0, 1), a2 + hstep, voffA);
            PG8_WAIT_L(8); PG8_BAR; PG8_WAIT_L(0); PG8_MMA(0, 0, At, B0); PG8_BAR; PG8_SCHED;
            PG8_LDB(B1, 1, 1); PG8_STAGE(PG8_SB(1, 0), b3, voffB);
            PG8_BAR; PG8_WAIT_L(0); PG8_MMA(0, 1, At, B1); PG8_BAR;
            PG8_LDA(At, 1, 1); PG8_STAGE(PG8_SA(1, 0), a3, voffA);
            PG8_BAR; PG8_WAIT_L(0); PG8_MMA(1, 0, At, B0); PG8_BAR; PG8_SCHED;
            PG8_STAGE(PG8_SB(1, 1), b3 + hstep, voffB);
            PG8_WAIT_V(6); PG8_BAR; PG8_MMA(1, 1, At, B1); PG8_BAR;
            }
        }
        if constexpr (ALIGN_EPI) { if (wr == 0) PG8_BAR; }
        if constexpr (!Epi::AFTER_DRAIN) { E(acc, cur, wr, wc, fr, fq); S.done(cur); }
        if (!has_next) break;
#pragma unroll
        for (int a = 0; a < 2; ++a)
#pragma unroll
            for (int b = 0; b < 2; ++b)
#pragma unroll
                for (int m = 0; m < 4; ++m)
#pragma unroll
                    for (int n = 0; n < 2; ++n) acc[a][b][m][n] = (f32x4){0.f, 0.f, 0.f, 0.f};
        cur = nxt; cA = nA; cB = nB; ++ui;
        if constexpr (ALIGN_EPI) { if (wr == 1) PG8_BAR; }
    }
    PG8_WAIT_V(0);
    if constexpr (!ALIGN_EPI) { if (wr == 0) PG8_BAR; }
    PG8_BAR;
    if constexpr (Epi::AFTER_DRAIN) { E.fused(acc, cur, wr, wc, fr, fq, lds, wid, lane); S.done(cur); }
#undef PG8_SA
#undef PG8_SB
#undef PG8_STAGE
#undef PG8_LDA
#undef PG8_LDB
#undef PG8_MMA
#undef PG8_WAIT_V
#undef PG8_WAIT_L
#undef PG8_BAR
#undef PG8_SCHED
}
}
namespace pg8 {
struct EpiP {
    static constexpr bool PERM = true, AFTER_DRAIN = false;
    bf16_t* O; int ldc;
    __device__ __forceinline__ void operator()(const f32x4 (&acc)[2][2][4][2], const Unit& u, int wr, int wc, int fr, int fq) const {
        const int row0 = u.pm * BM + wr * 64 + fr; const int col0 = u.pn * BM + wc * 32 + 8 * fq;
#pragma unroll
        for (int ai = 0; ai < 2; ++ai)
#pragma unroll
            for (int m = 0; m < 4; ++m) { bf16_t* rowp = O + (size_t)(row0 + ai * HALF + m * 16) * ldc + col0;
#pragma unroll
                for (int bj = 0; bj < 2; ++bj) { const f32x4 v0 = acc[ai][bj][m][0], v1 = acc[ai][bj][m][1];
                    u32x4 w; w.x = cvt_pk_bf16(v0[0], v0[1]); w.y = cvt_pk_bf16(v0[2], v0[3]); w.z = cvt_pk_bf16(v1[0], v1[1]); w.w = cvt_pk_bf16(v1[2], v1[3]);
                    *(u32x4*)(rowp + bj * HALF) = w; } }
    }
};
struct EpiY {
    static constexpr bool PERM = false, AFTER_DRAIN = false;
    float* C; int ldc;
    __device__ __forceinline__ void operator()(const f32x4 (&acc)[2][2][4][2], const Unit& u, int wr, int wc, int fr, int fq) const {
        const int row0 = u.pm * BM + wr * 64 + fr, col0 = u.pn * BM + wc * 32 + 4 * fq;
#pragma unroll
        for (int ai = 0; ai < 2; ++ai)
#pragma unroll
            for (int m = 0; m < 4; ++m) { float* rowp = C + (size_t)(row0 + ai * HALF + m * 16) * ldc + col0;
#pragma unroll
                for (int bj = 0; bj < 2; ++bj)
#pragma unroll
                    for (int n = 0; n < 2; ++n) *(f32x4*)(rowp + bj * HALF + n * 16) = acc[ai][bj][m][n]; }
    }
};
struct LatentOrder : StaticOrder {
    __host__ __device__ bool next(int i, Unit& u) const { if (!StaticOrder::next(i, u)) return false; u.pm = u.pm + u.pm / 16 + 1; return true; }
};
}

#ifndef PH_MASK
#define PH_MASK 0xfff
#endif
#ifndef DUP_MASK
#define DUP_MASK 0
#endif
#ifndef MIX_DUP
#define MIX_DUP 0
#endif
#ifndef USE_VALU_SCAN
#define USE_VALU_SCAN 0
#endif
#ifndef SCAN_DUP
#define SCAN_DUP 0
#endif
#ifndef SCAN_XBAR
#define SCAN_XBAR 0
#endif
#ifndef MIX_MASK
#define MIX_MASK 7
#endif
using pg8::bf16_t; using pg8::bf16x8; using pg8::f32x4; using pg8::u32x4;
typedef float f32x2 __attribute__((ext_vector_type(2)));
typedef float f32x16 __attribute__((ext_vector_type(16)));
typedef unsigned u32x2 __attribute__((ext_vector_type(2)));
#define LAS __attribute__((address_space(3)))

constexpr int D = 2048, NBATCH = 4, SEQ = 4096, CTXL = 256, TT = SEQ + CTXL, MROWS = NBATCH * TT;
constexpr int NPW = 7696, NP = 7936, NMOD = 6144;
constexpr float EPS = 1e-6f;
constexpr int C_AQ = 0, C_AFF = 512, C_AFB = 1024, C_AI = 1536, C_BQ = 2048, C_BK = 2560, C_BV = 3072, C_GT = 3584,
              C_CQ = 3840, C_CK = 4864, C_CV = 5120, C_CZ = 5376, C_AG = 6400, C_BO = 6912, C_BZ = 7424;
constexpr int NX = 15 * 256, NY1 = NP - NX, SCAN_WGS = 64;
constexpr size_t WS_WIN  = 0;
constexpr size_t WS_WOUT = WS_WIN  + (size_t)2 * NP * D * 2;
constexpr size_t WS_A    = WS_WOUT + (size_t)2 * D * D * 2;
constexpr size_t WS_P    = WS_A    + (size_t)MROWS * D * 2;
constexpr size_t WS_HCTX = WS_P    + (size_t)MROWS * NP * 2;
constexpr size_t WS_O    = WS_HCTX + (size_t)NBATCH * CTXL * D * 4;
constexpr size_t WS_MOD  = WS_O    + (size_t)2 * MROWS * 1024 * 2;
constexpr size_t WS_BAR  = WS_MOD  + (size_t)2 * 5 * NMOD * 4;
constexpr size_t WS_XBAR = WS_BAR + 1024;
constexpr size_t WS_ROPE = WS_XBAR + 16384;
constexpr size_t WS_END  = WS_ROPE + (size_t)64 * 32 * 8;
constexpr int LDS_BYTES = 131072 + 64;
constexpr int NPHASE = 12;

struct Params { const float* in[14]; float* out; unsigned char* ws; int ph_lo, ph_hi; };

__device__ __forceinline__ float bf2f(unsigned h) { return __uint_as_float(h << 16); }
__device__ __forceinline__ float bflo(unsigned w) { return __uint_as_float(w << 16); }
__device__ __forceinline__ float bfhi(unsigned w) { return __uint_as_float(w & 0xffff0000u); }
typedef __bf16 bf16v2_t __attribute__((ext_vector_type(2)));
__device__ __forceinline__ unsigned pk2(float a, float b) { const f32x2 v = {a, b}; const bf16v2_t r = __builtin_convertvector(v, bf16v2_t); return __builtin_bit_cast(unsigned, r); }
__device__ __forceinline__ float sigm(float x) { return __builtin_amdgcn_rcpf(1.f + __expf(-x)); }
__device__ __forceinline__ float siluf(float x) { return x * __builtin_amdgcn_rcpf(1.f + __expf(-x)); }
__device__ __forceinline__ float wave_sum(float v) {
#pragma unroll
    for (int o = 1; o < 64; o <<= 1) v += __shfl_xor(v, o);
    return v;
}
__device__ __forceinline__ float rdlane_f(float v, int l) { return __int_as_float(__builtin_amdgcn_readlane(__float_as_int(v), l)); }
__device__ __forceinline__ void st_b64_untracked(void* ptr, u32x2 v) { asm volatile("global_store_dwordx2 %0, %1, off" :: "v"(ptr), "v"(v) : "memory"); }
__device__ __forceinline__ void touch4(unsigned a, unsigned b, unsigned c, unsigned d) { asm volatile("" :: "v"(a), "v"(b), "v"(c), "v"(d)); }
#define LDS_WAIT() asm volatile("s_waitcnt lgkmcnt(0)" ::: "memory")

__device__ __forceinline__ int orig_col(int c) {
    return c < 2048 ? c : (c < 3584 ? c + 512 : (c < 3600 ? c + 1024 : (c < 3840 ? -1 : (c < 6400 ? c + 1296 : (c < 6912 ? c - 4352 : (c < 7424 ? c - 2816 : c - 2800))))));
}
template <bool REMAP>
__device__ __forceinline__ void p0_transpose_item(const float* W, int K, int N, bf16_t* WT, LAS float* scr, int item, int nblk, int lane) {
    const int kb = item / nblk, nb = item % nblk, k0 = 64 * kb, n0 = 32 * nb;
    const int cc = n0 + (lane & 31); const int oc = REMAP ? orig_col(cc) : cc;
    float wv_[32];
#pragma unroll
    for (int i = 0; i < 32; ++i) { const int kk = 2 * i + (lane >> 5); wv_[i] = (oc >= 0) ? W[(size_t)(k0 + kk) * N + oc] : 0.f; }
#pragma unroll
    for (int i = 0; i < 32; ++i) { const int kk = 2 * i + (lane >> 5); scr[kk * 33 + (lane & 31)] = wv_[i]; }
    LDS_WAIT(); asm volatile("" ::: "memory");
    const int c = lane & 7;
#pragma unroll
    for (int j = 0; j < 4; ++j) { const int n = (lane >> 3) + 8 * j; const LAS float* s = scr + (8 * c) * 33 + n;
        u32x4 o; o.x = pk2(s[0 * 33], s[1 * 33]); o.y = pk2(s[2 * 33], s[3 * 33]); o.z = pk2(s[4 * 33], s[5 * 33]); o.w = pk2(s[6 * 33], s[7 * 33]);
        *(u32x4*)(WT + (size_t)(n0 + n) * K + k0 + 8 * c) = o; }
    LDS_WAIT(); asm volatile("" ::: "memory");
}
__device__ __forceinline__ void weight_transposes(const Params& p, LAS unsigned char* lds, int l, int gw, int NGW) {
    const int lane = opaque_tid() & 63, wave = (opaque_tid() >> 6) & 7;
    LAS float* scr = (LAS float*)(lds + wave * 16384);
    bf16_t* WinT = (bf16_t*)(p.ws + WS_WIN); bf16_t* WoutT = (bf16_t*)(p.ws + WS_WOUT);
    constexpr int I_IN = (D / 64) * (NP / 32), I_OUT = (D / 64) * (D / 32), NITEMS = I_IN + I_OUT;
    for (int it = gw; it < NITEMS; it += NGW) {
        if (it < I_IN) p0_transpose_item<true>(p.in[8] + (size_t)l * D * NPW, D, NPW, WinT + (size_t)l * NP * D, scr, it, NP / 32, lane);
        else p0_transpose_item<false>(p.in[13] + (size_t)l * D * D, D, D, WoutT + (size_t)l * D * D, scr, it - I_IN, D / 32, lane);
    }
}
__device__ __forceinline__ void p0_prologue(const Params& p, LAS unsigned char* lds) {
    const int tid = opaque_tid(), lane = tid & 63, wave = tid >> 6;
    LAS float* scr = (LAS float*)(lds + wave * 16384);
    const int gw = blockIdx.x * 8 + wave, NGW = gridDim.x * 8;
    bf16_t* WinT = (bf16_t*)(p.ws + WS_WIN); bf16_t* WoutT = (bf16_t*)(p.ws + WS_WOUT);
    float* mod = (float*)(p.ws + WS_MOD);
    if (blockIdx.x == 0) {
        float* tab = (float*)(p.ws + WS_ROPE);
        for (int idx = tid; idx < 64 * 32; idx += 512) { const int pos = idx >> 5, i = idx & 31;
            const float inv = __builtin_amdgcn_exp2f(-(float)i * (13.287712379549449f / 32.f)); const float ang = (float)pos * inv;
            tab[2 * idx] = __cosf(ang); tab[2 * idx + 1] = __sinf(ang); }
    }
    constexpr int MOD_TASKS = 2 * 96 * 16;
    for (int task = gw; task < MOD_TASKS; task += NGW) {
        const int l = task / 1536, r = task % 1536, cgp = r % 96, kr = r / 96, n = cgp * 64 + lane, k0 = kr * 128;
        for (int idx = lane; idx < 640; idx += 64) { const int v = idx >> 7, kk = idx & 127; const float s = (v < 4) ? p.in[1][v * D + k0 + kk] : p.in[3][k0 + kk]; scr[idx] = siluf(s); }
        LDS_WAIT(); asm volatile("" ::: "memory");
        float acc[5] = {0.f, 0.f, 0.f, 0.f, 0.f};
        const float* wp = p.in[4] + (size_t)l * D * NMOD + (size_t)k0 * NMOD + n;
#pragma unroll 8
        for (int kk = 0; kk < 128; ++kk) { const float w = wp[(size_t)kk * NMOD];
#pragma unroll
            for (int v = 0; v < 5; ++v) acc[v] += scr[v * 128 + kk] * w; }
        if (kr == 0) { const float bb = p.in[5][l * NMOD + n];
#pragma unroll
            for (int v = 0; v < 5; ++v) acc[v] += bb; }
#pragma unroll
        for (int v = 0; v < 5; ++v) atomicAdd(mod + ((size_t)l * 5 + v) * NMOD + n, acc[v]);
        LDS_WAIT(); asm volatile("" ::: "memory");
    }
    const bool defer1 = (int)gridDim.x > 2 * SCAN_WGS;
    weight_transposes(p, lds, 0, gw, NGW);
    if (!defer1) weight_transposes(p, lds, 1, gw, NGW);
}

__device__ __forceinline__ void post_stage(f32x4 (&v)[8], const f32x4 (&y)[8], float rs, const float* __restrict__ gp, const float* __restrict__ gate, float* __restrict__ dst, int lane, bool nt) {
#pragma unroll
    for (int h2 = 0; h2 < 2; ++h2) {
        f32x4 g[4], ga[4];
#pragma unroll
        for (int j = 0; j < 4; ++j) { g[j] = *((const f32x4*)gp + lane + 64 * (4 * h2 + j)); ga[j] = *((const f32x4*)gate + lane + 64 * (4 * h2 + j)); }
#pragma unroll
        for (int j = 0; j < 4; ++j) { const int jj = 4 * h2 + j; v[jj] = v[jj] + ga[j] * (y[jj] * rs * g[j]); if (nt) __builtin_nontemporal_store(v[jj], (f32x4*)dst + lane + 64 * jj); else *((f32x4*)dst + lane + 64 * jj) = v[jj]; }
    }
}
__device__ __forceinline__ void pre_stage(const f32x4 (&v)[8], float rs, const float* __restrict__ gp, const float* __restrict__ sc, const float* __restrict__ sh, u32x2* __restrict__ ar, int lane) {
#pragma unroll
    for (int h2 = 0; h2 < 2; ++h2) {
        f32x4 g[4], s1[4], s0[4];
#pragma unroll
        for (int j = 0; j < 4; ++j) { g[j] = *((const f32x4*)gp + lane + 64 * (4 * h2 + j)); s1[j] = *((const f32x4*)sc + lane + 64 * (4 * h2 + j)); s0[j] = *((const f32x4*)sh + lane + 64 * (4 * h2 + j)); }
#pragma unroll
        for (int j = 0; j < 4; ++j) { const f32x4 o = (v[4 * h2 + j] * rs * g[j]) * (s1[j] + 1.f) + s0[j]; u32x2 w; w.x = pk2(o.x, o.y); w.y = pk2(o.z, o.w); ar[lane + 64 * (4 * h2 + j)] = w; }
    }
}
template <int MODE, int NR>
__device__ __forceinline__ void row_body(const Params& p, int m0, int mstride, int lane) {
    const float* mod = (const float*)(p.ws + WS_MOD);
    const bf16_t* Yout = (const bf16_t*)(p.ws + WS_P);
    float* hctx = (float*)(p.ws + WS_HCTX);
    bf16_t* A = (bf16_t*)(p.ws + WS_A);
    f32x4 v[NR][8]; f32x4 y[NR][8]; int mv[NR]; float* dst[NR]; int mrow[NR];
#pragma unroll
    for (int q = 0; q < NR; ++q) {
        const int m = m0 + q * mstride; mrow[q] = m;
        const int b = m / TT, tok = m - b * TT; const bool isctx = tok < CTXL;
        mv[q] = isctx ? 4 : b;
        const float* src;
        if (MODE <= 1) src = isctx ? p.in[2] + ((size_t)b * CTXL + tok) * D : p.in[0] + ((size_t)b * SEQ + (tok - CTXL)) * D;
        else src = p.out + ((size_t)b * SEQ + (tok - CTXL)) * D;
        if (MODE == 0) dst[q] = nullptr;
        else if (MODE == 1) dst[q] = isctx ? hctx + ((size_t)b * CTXL + tok) * D : p.out + ((size_t)b * SEQ + (tok - CTXL)) * D;
        else dst[q] = p.out + ((size_t)b * SEQ + (tok - CTXL)) * D;
#pragma unroll
        for (int j = 0; j < 8; ++j) v[q][j] = __builtin_nontemporal_load((const f32x4*)src + lane + 64 * j);
        if (MODE >= 1) { const bf16_t* yr = Yout + (size_t)m * D;
#pragma unroll
            for (int j = 0; j < 8; ++j) { const u32x2 yw = __builtin_nontemporal_load((const u32x2*)yr + lane + 64 * j); y[q][j] = (f32x4){bflo(yw.x), bfhi(yw.x), bflo(yw.y), bfhi(yw.y)}; } }
    }
    if (MODE >= 1) {
        const int lpost = MODE - 1; const float* gp = p.in[7] + lpost * D;
#pragma unroll
        for (int q = 0; q < NR; ++q) {
            const float* gate = mod + ((size_t)lpost * 5 + mv[q]) * NMOD + 2 * D; float ss = 0.f;
#pragma unroll
            for (int j = 0; j < 8; ++j) ss += (y[q][j].x * y[q][j].x + y[q][j].y * y[q][j].y) + (y[q][j].z * y[q][j].z + y[q][j].w * y[q][j].w);
            const float rs = __builtin_amdgcn_rsqf(wave_sum(ss) * (1.f / D) + EPS);
            post_stage(v[q], y[q], rs, gp, gate, dst[q], lane, MODE == 2);
        }
    }
    if (MODE <= 1) {
        const int lpre = MODE; const float* gp = p.in[6] + lpre * D;
#pragma unroll
        for (int q = 0; q < NR; ++q) {
            const float* sh = mod + ((size_t)lpre * 5 + mv[q]) * NMOD; const float* sc = sh + D; float ss = 0.f;
#pragma unroll
            for (int j = 0; j < 8; ++j) ss += (v[q][j].x * v[q][j].x + v[q][j].y * v[q][j].y) + (v[q][j].z * v[q][j].z + v[q][j].w * v[q][j].w);
            const float rs = __builtin_amdgcn_rsqf(wave_sum(ss) * (1.f / D) + EPS);
            pre_stage(v[q], rs, gp, sc, sh, (u32x2*)(A + (size_t)mrow[q] * D), lane);
        }
    }
}
template <int MODE>
__device__ __forceinline__ void row_phase(const Params& p) {
    const int tid = opaque_tid(), lane = tid & 63, wave = tid >> 6;
    const int gw = blockIdx.x * 8 + wave, NGW = gridDim.x * 8;
    if (MODE == 2) {
        int r = gw;
        for (; r + NGW < NBATCH * SEQ; r += 2 * NGW) { const int ma = (r / SEQ) * TT + CTXL + (r % SEQ), r2 = r + NGW, mb = (r2 / SEQ) * TT + CTXL + (r2 % SEQ); row_body<MODE, 2>(p, ma, mb - ma, lane); }
        if (r < NBATCH * SEQ) row_body<MODE, 1>(p, (r / SEQ) * TT + CTXL + (r % SEQ), 0, lane);
    } else if (MODE == 0) {
        int m = gw;
        for (; m + 3 * NGW < MROWS; m += 4 * NGW) row_body<MODE, 4>(p, m, NGW, lane);
        for (; m < MROWS; m += NGW) row_body<MODE, 1>(p, m, 0, lane);
    } else {
        int m = gw;
        for (; m + NGW < MROWS; m += 2 * NGW) row_body<MODE, 2>(p, m, NGW, lane);
        if (m < MROWS) row_body<MODE, 1>(p, m, 0, lane);
    }
}

constexpr int TC = 16, NCH = TT / TC;
constexpr int SC_A = 0, SC_B = SC_A + TC * 128 * 4, SC_Q = SC_B + TC * 128 * 4, SC_V = SC_Q + TC * 128 * 4, SC_O = SC_V + TC * 36 * 4, SC_N = SC_O + TC * 8 * 32 * 4, SC_END = SC_N + TC * 64 * 4;
template <int CTRL> __device__ __forceinline__ float dpp_quad(float v) { return __int_as_float(__builtin_amdgcn_mov_dpp(__float_as_int(v), CTRL, 0xf, 0xf, true)); }

template <int BR>
__device__ __forceinline__ void scan_unit(const Params& p, int layer, int unit, LAS unsigned char* lds) {
    const int tid = opaque_tid(), lane = tid & 63, wave = tid >> 6;
    const int dir = (unit >> 6) & 1, b = (unit >> 4) & 3, h = (unit >> 2) & 3, colq = unit & 3;
    const bf16_t* P = (const bf16_t*)(p.ws + WS_P);
    bf16_t* Ob = (bf16_t*)(p.ws + WS_O) + (size_t)dir * MROWS * 1024 + BR * 512 + h * 128 + colq * 32;
    LAS float* SA = (LAS float*)(lds + SC_A); LAS float* SB = (LAS float*)(lds + SC_B); LAS float* SQ = (LAS float*)(lds + SC_Q);
    LAS float* SV = (LAS float*)(lds + SC_V); LAS float* OB = (LAS float*)(lds + SC_O); LAS float* NBF = (LAS float*)(lds + SC_N);
    const int ts = tid >> 5, lj = tid & 31;
    float lb[4] = {0.f, 0.f, 0.f, 0.f};
    float cwq[3][4], cwk[3][4]; float bias_i = 0.f, bias_f = 0.f;
    if (BR == 0) {
        if (layer == 1) {
#pragma unroll
            for (int e = 0; e < 4; ++e) { const int idx = dir * 512 + h * 128 + 4 * lj + e; lb[e] = sigm(p.in[9][1024 + idx] - p.in[9][idx]); }
        }
    } else {
        const float* cw = p.in[10] + (size_t)layer * 3 * 1024;
#pragma unroll
        for (int tp = 0; tp < 3; ++tp)
#pragma unroll
            for (int e = 0; e < 4; ++e) { cwq[tp][e] = cw[tp * 1024 + h * 128 + 4 * lj + e]; cwk[tp][e] = cw[tp * 1024 + 512 + h * 128 + 4 * lj + e]; }
        bias_i = p.in[11][layer * 16 + (2 * dir) * 4 + h]; bias_f = p.in[11][layer * 16 + (2 * dir + 1) * 4 + h];
    }
    u32x2 rq[3], rk[3]; unsigned rv = 0, rgi = 0, rgf = 0; int mrow = 0; float okf[3] = {1.f, 1.f, 1.f};
    auto issue = [&](int ch) {
        const int t = ch * TC + ts; const int tok = dir ? (t < CTXL ? (CTXL - 1 - t) : (TT + CTXL - 1 - t)) : t;
        mrow = b * TT + tok;
        const bf16_t* pr = P + (size_t)mrow * NP;
        if (BR == 0) {
            rq[0] = *(const u32x2*)(pr + C_AQ + h * 128 + 4 * lj);
            rk[0] = *(const u32x2*)(pr + (dir ? C_AFB : C_AFF) + h * 128 + 4 * lj);
            rv = pr[C_AI + h * 128 + colq * 32 + lj];
        } else {
            const int lo = tok < CTXL ? 0 : CTXL, hi = tok < CTXL ? CTXL - 1 : TT - 1;
#pragma unroll
            for (int tp = 0; tp < 3; ++tp) { const int tn = tok + tp - 1; const bool ok = (tn >= lo) && (tn <= hi); const bf16_t* pn = P + (size_t)(b * TT + (ok ? tn : tok)) * NP;
                rq[tp] = *(const u32x2*)(pn + C_BQ + h * 128 + 4 * lj); rk[tp] = *(const u32x2*)(pn + C_BK + h * 128 + 4 * lj); okf[tp] = ok ? 1.f : 0.f; }
            rv = pr[C_BV + h * 128 + colq * 32 + lj];
            rgi = pr[C_GT + (2 * dir) * 4 + h]; rgf = pr[C_GT + (2 * dir + 1) * 4 + h];
        }
    };
    auto convert = [&]() {
        f32x4 av, bv, qv; float vv;
        if (BR == 0) {
            const float zq[4] = {bflo(rq[0].x), bfhi(rq[0].x), bflo(rq[0].y), bfhi(rq[0].y)};
            const float zf[4] = {bflo(rk[0].x), bfhi(rk[0].x), bflo(rk[0].y), bfhi(rk[0].y)};
#pragma unroll
            for (int e = 0; e < 4; ++e) { const float kk = (1.f - lb[e]) * sigm(-zf[e]); bv[e] = kk; av[e] = 1.f - kk; qv[e] = siluf(zq[e]); }
            vv = bf2f(rv);
        } else {
            const float fg = sigm(bf2f(rgf) + bias_f), ig = __expf(bf2f(rgi) + bias_i);
            float cq[4] = {0.f, 0.f, 0.f, 0.f}, ck[4] = {0.f, 0.f, 0.f, 0.f};
#pragma unroll
            for (int tp = 0; tp < 3; ++tp) {
                const float xq[4] = {bflo(rq[tp].x), bfhi(rq[tp].x), bflo(rq[tp].y), bfhi(rq[tp].y)};
                const float xk[4] = {bflo(rk[tp].x), bfhi(rk[tp].x), bflo(rk[tp].y), bfhi(rk[tp].y)};
#pragma unroll
                for (int e = 0; e < 4; ++e) { cq[e] += (cwq[tp][e] * okf[tp]) * xq[e]; ck[e] += (cwk[tp][e] * okf[tp]) * xk[e]; }
            }
#pragma unroll
            for (int e = 0; e < 4; ++e) { av[e] = fg; bv[e] = siluf(ck[e]); qv[e] = siluf(cq[e]) * 0.08838834764831845f; }
            vv = bf2f(rv) * ig;
            if (lj == 0) SV[ts * 36 + 32] = ig;
        }
        *(LAS f32x4*)(SA + ts * 128 + 4 * lj) = av; *(LAS f32x4*)(SB + ts * 128 + 4 * lj) = bv; *(LAS f32x4*)(SQ + ts * 128 + 4 * lj) = qv;
        SV[ts * 36 + lj] = vv;
    };
    const int cp = lane >> 2, dq = lane & 3, d0 = wave * 16 + dq * 4;
    f32x2 S[2][2]; S[0][0] = S[0][1] = S[1][0] = S[1][1] = (f32x2){0.f, 0.f};
    issue(0); convert();
    __syncthreads();
    f32x2 nn = {0.f, 0.f};
    for (int ch = 0; ch < NCH; ++ch) {
        const int mrow_cur = mrow;
        if (ch + 1 < NCH) issue(ch + 1);
        f32x4 ga[2][4], gb[2][4], gq[2][4]; f32x2 gv[2][4];
#define SC_LOADG(bufi, g) do { _Pragma("unroll") for (int k = 0; k < 4; ++k) { const int s_ = 4 * (g) + k; \
            ga[bufi][k] = *(const LAS f32x4*)(SA + s_ * 128 + d0); gb[bufi][k] = *(const LAS f32x4*)(SB + s_ * 128 + d0); gq[bufi][k] = *(const LAS f32x4*)(SQ + s_ * 128 + d0); \
            gv[bufi][k] = *(const LAS f32x2*)(SV + s_ * 36 + 2 * cp); } } while (0)
        SC_LOADG(0, 0);
#pragma unroll
        for (int g = 0; g < 4; ++g) {
            const int cb = g & 1;
            if (g < 3) SC_LOADG(cb ^ 1, g + 1);
            float ov[4];
#pragma unroll
            for (int k = 0; k < 4; ++k) {
                const f32x4 a = ga[cb][k], bb = gb[cb][k], q = gq[cb][k]; const f32x2 v = gv[cb][k];
                const f32x2 a0 = {a.x, a.y}, a1 = {a.z, a.w}, b0 = {bb.x, bb.y}, b1 = {bb.z, bb.w}, q0 = {q.x, q.y}, q1 = {q.z, q.w};
                float o[2];
#pragma unroll
                for (int c = 0; c < 2; ++c) {
                    const f32x2 vc = {v[c], v[c]};
                    S[c][0] = a0 * S[c][0] + b0 * vc; S[c][1] = a1 * S[c][1] + b1 * vc;
                    const f32x2 t2 = S[c][0] * q0 + S[c][1] * q1; o[c] = t2.x + t2.y;
                }
                o[0] += dpp_quad<0xB1>(o[0]); o[1] += dpp_quad<0xB1>(o[1]);
                o[0] += dpp_quad<0x4E>(o[0]); o[1] += dpp_quad<0x4E>(o[1]);
                ov[k] = (dq & 1) ? o[1] : o[0];
            }
#pragma unroll
            for (int k = 0; k < 4; ++k) OB[((4 * g + k) * 8 + wave) * 32 + 2 * cp + (dq & 1)] = ov[k];
        }
        if (BR == 1 && wave == 7) {
#pragma unroll
            for (int s = 0; s < TC; ++s) {
                const f32x2 b2 = *(const LAS f32x2*)(SB + s * 128 + 2 * lane), q2 = *(const LAS f32x2*)(SQ + s * 128 + 2 * lane);
                const float fg = SA[s * 128], ig = SV[s * 36 + 32];
                nn = nn * fg + b2 * ig;
                NBF[s * 64 + lane] = nn.x * q2.x + nn.y * q2.y;
            }
        }
        __syncthreads();
        if (ch + 1 < NCH) convert();
        {
            float num = 0.f;
#pragma unroll
            for (int w = 0; w < 8; ++w) num += OB[(ts * 8 + w) * 32 + lj];
            if (BR == 1) { float den = NBF[ts * 64 + lj] + NBF[ts * 64 + 32 + lj];
                den += __shfl_xor(den, 1); den += __shfl_xor(den, 2); den += __shfl_xor(den, 4); den += __shfl_xor(den, 8); den += __shfl_xor(den, 16);
                num = num / fmaxf(fabsf(den), 1.f); }
            Ob[(size_t)mrow_cur * 1024 + lj] = (bf16_t)(pk2(num, 0.f) & 0xffffu);
        }
        __syncthreads();
    }
#undef SC_LOADG
}

#define MFMA32(a, b, c) __builtin_amdgcn_mfma_f32_32x32x16_bf16((a), (b), (c), 0, 0, 0)
constexpr int ML = 32, MNCH = TT / ML;
constexpr int MS_ROW = 272, MS_TROW = 80;
constexpr int MS_QT = 0, MS_BT = MS_QT + 32 * MS_ROW, MS_BTT = MS_BT + 32 * MS_ROW, MS_VT = MS_BTT + 128 * MS_TROW, MS_AL = MS_VT + 128 * MS_TROW,
              MS_IV = MS_AL + 512, MS_NV = MS_IV + 128, MS_XA = MS_NV + 1024, MS_XO = MS_XA + 5120, MS_GRP = MS_XO + 16384;
__device__ __forceinline__ bf16x8 pack8(const f32x16& x, int s) {
    u32x4 w; w.x = pk2(x[8 * s], x[8 * s + 1]); w.y = pk2(x[8 * s + 2], x[8 * s + 3]); w.z = pk2(x[8 * s + 4], x[8 * s + 5]); w.w = pk2(x[8 * s + 6], x[8 * s + 7]);
    return __builtin_bit_cast(bf16x8, w);
}
__device__ __forceinline__ bf16x8 ld2x64(const LAS unsigned char* p0) {
    const u32x2 lo = *(const LAS u32x2*)(p0), hi = *(const LAS u32x2*)(p0 + 16);
    u32x4 w; w.x = lo.x; w.y = lo.y; w.z = hi.x; w.w = hi.y; return __builtin_bit_cast(bf16x8, w);
}
template <int BR>
__device__ __forceinline__ void scan_mfma(const Params& p, int layer, int seq, LAS unsigned char* lds) {
    const int tid = opaque_tid(), lane = tid & 63, wave = __builtin_amdgcn_readfirstlane(tid >> 6), wv = wave & 3, dh = wave >> 2, r = lane & 31, hh = lane >> 5;
    const int dir = (seq >> 4) & 1, b = (seq >> 2) & 3, h = seq & 3;
    LAS float* AL = (LAS float*)(lds + MS_AL); LAS float* IV = (LAS float*)(lds + MS_IV); LAS float* NV = (LAS float*)(lds + MS_NV); LAS float* XA = (LAS float*)(lds + MS_XA);
    LAS float* XO = (LAS float*)(lds + MS_XO);
    const bf16_t* P = (const bf16_t*)(p.ws + WS_P);
    bf16_t* Ob = (bf16_t*)(p.ws + WS_O) + (size_t)dir * MROWS * 1024 + BR * 512 + h * 128;
    const int colA = h * 128 + 2 * lane;
    const int cF = dir ? C_AFB : C_AFF;
    float lb[2] = {0.f, 0.f}; float cwq[3][2], cwk[3][2]; float bias_g = 0.f;
    if (BR == 0) { if (layer == 1) {
#pragma unroll
            for (int e = 0; e < 2; ++e) { const int idx = dir * 512 + colA + e; lb[e] = sigm(p.in[9][1024 + idx] - p.in[9][idx]); } }
    } else {
        const float* cw = p.in[10] + (size_t)layer * 3 * 1024;
#pragma unroll
        for (int tp = 0; tp < 3; ++tp)
#pragma unroll
            for (int e = 0; e < 2; ++e) { cwq[tp][e] = cw[tp * 1024 + colA + e]; cwk[tp][e] = cw[tp * 1024 + 512 + colA + e]; }
        bias_g = p.in[11][layer * 16 + 8 * dir + 4 * (lane & 1) + h];
    }
    unsigned rq[2][6], rk[2][6], rv[2][4], rg[2] = {0u, 0u}; float oklo[2] = {1.f, 1.f}, okhi[2] = {1.f, 1.f};
    auto tok_of = [&](int t) { return dir ? (t < CTXL ? (CTXL - 1 - t) : (TT + CTXL - 1 - t)) : t; };
    const char* Pb = (const char*)P;
#define LDU32(byteoff) (*(const unsigned*)(Pb + (unsigned)(byteoff)))
    auto issue = [&](int ch, auto SETC) {
        constexpr int st = decltype(SETC)::value;
        const int t0 = (ch < MNCH ? ch : MNCH - 1) * ML + 4 * wave;
        constexpr unsigned RB = 2u * NP;
        if (BR == 0) {
            const unsigned o0 = ((unsigned)(b * TT + tok_of(t0)) * (unsigned)NP + (unsigned)colA) * 2u;
#pragma unroll
            for (int k = 0; k < 4; ++k) { const unsigned o = dir ? o0 - (unsigned)k * RB : o0 + (unsigned)k * RB;
                rq[st][k] = LDU32(o + 2u * C_AQ); rk[st][k] = LDU32(o + 2u * (unsigned)cF); rv[st][k] = LDU32(o + 2u * C_AI); }
        } else {
            const int tk0 = dir ? tok_of(t0 + 3) : tok_of(t0);
            const int lo = tk0 < CTXL ? 0 : CTXL, hi = tk0 < CTXL ? CTXL - 1 : TT - 1;
            oklo[st] = (tk0 > lo) ? 1.f : 0.f; okhi[st] = (tk0 + 3 < hi) ? 1.f : 0.f;
            const unsigned o0 = ((unsigned)(b * TT + tk0) * (unsigned)NP + (unsigned)colA) * 2u;
#pragma unroll
            for (int w = 0; w < 6; ++w) { const unsigned o = (w == 0) ? (tk0 > lo ? o0 - RB : o0) : ((w == 5) ? (tk0 + 3 < hi ? o0 + 4u * RB : o0 + 3u * RB) : o0 + (unsigned)(w - 1) * RB);
                rq[st][w] = LDU32(o + 2u * C_BQ); rk[st][w] = LDU32(o + 2u * C_BK); }
#pragma unroll
            for (int k = 0; k < 4; ++k) { const unsigned o = o0 + (unsigned)(dir ? 3 - k : k) * RB; rv[st][k] = LDU32(o + 2u * C_BV); }
            { const int k = (lane >> 1) & 3; const unsigned o = ((unsigned)(b * TT + tk0 + (dir ? 3 - k : k)) * (unsigned)NP + (unsigned)(C_GT + 8 * dir + 4 * (lane & 1) + h)) * 2u; rg[st] = *(const unsigned short*)(Pb + o); }
        }
    };
#undef LDU32
    float gvec = 0.f; float hb[4][2] = {{0.f, 0.f}, {0.f, 0.f}, {0.f, 0.f}, {0.f, 0.f}};
    auto part1 = [&](auto SETC) {
        constexpr int st = decltype(SETC)::value;
        float run0 = 1.f, run1 = 1.f;
        if (BR == 0) {
#pragma unroll
            for (int k = 0; k < 4; ++k) { hb[k][0] = (1.f - lb[0]) * sigm(-bflo(rk[st][k])); hb[k][1] = (1.f - lb[1]) * sigm(-bfhi(rk[st][k])); run0 *= (1.f - hb[k][0]); run1 *= (1.f - hb[k][1]); }
        } else {
            gvec = (lane & 1) ? sigm(bf2f(rg[st]) + bias_g) : __expf(bf2f(rg[st]) + bias_g);
#pragma unroll
            for (int k = 0; k < 4; ++k) run0 *= rdlane_f(gvec, 2 * k + 1);
            run1 = run0;
        }
        if (BR == 0) *(LAS f32x2*)(XA + wave * 128 + 2 * lane) = (f32x2){run0, run1};
        else if (lane == 0) XA[9 * 128 + wave] = run0;
        touch4(rq[st][0], rq[st][1], rq[st][2], rq[st][3]); touch4(rv[st][0], rv[st][1], rv[st][2], rv[st][3]);
        if (BR == 1) { touch4(rq[st][4], rq[st][5], rk[st][0], rk[st][1]); touch4(rk[st][2], rk[st][3], rk[st][4], rk[st][5]); }
    };
    auto part2 = [&](auto SETC) {
        constexpr int st = decltype(SETC)::value;
        float run0 = 1.f, run1 = 1.f;
        if (BR == 0) {
#pragma unroll
            for (int q0 = 0; q0 < 8; q0 += 4) {
                f32x2 xs[4];
#pragma unroll
                for (int qd = 0; qd < 4; ++qd) xs[qd] = *(const LAS f32x2*)(XA + ((q0 + qd) < wave ? (q0 + qd) : 8) * 128 + 2 * lane);
#pragma unroll
                for (int qd = 0; qd < 4; ++qd) { run0 *= xs[qd].x; run1 *= xs[qd].y; }
            }
        } else {
            const f32x4 x0 = *(const LAS f32x4*)(XA + 9 * 128), x1 = *(const LAS f32x4*)(XA + 9 * 128 + 4);
            const float xv[8] = {x0.x, x0.y, x0.z, x0.w, x1.x, x1.y, x1.z, x1.w};
#pragma unroll
            for (int qd = 0; qd < 7; ++qd) run0 *= (qd < wave) ? xv[qd] : 1.f;
            run1 = run0;
        }
        unsigned bt0[2], bt1[2], vt0[2], vt1[2]; float bprev0 = 0.f, bprev1 = 0.f, vprev0 = 0.f, vprev1 = 0.f;
        if (BR == 1) { if (oklo[st] == 0.f) { rq[st][0] = 0u; rk[st][0] = 0u; } if (okhi[st] == 0.f) { rq[st][5] = 0u; rk[st][5] = 0u; } }
#pragma unroll
        for (int k = 0; k < 4; ++k) {
            float q0, q1, b0, b1, v0, v1;
            if (BR == 0) {
                b0 = hb[k][0]; b1 = hb[k][1];
                run0 *= (1.f - b0); run1 *= (1.f - b1);
                q0 = siluf(bflo(rq[st][k])); q1 = siluf(bfhi(rq[st][k])); v0 = bflo(rv[st][k]); v1 = bfhi(rv[st][k]);
            } else {
                const float ig = rdlane_f(gvec, 2 * k), fg = rdlane_f(gvec, 2 * k + 1);
                const int wc = 1 + (dir ? 3 - k : k);
                float cq0 = 0.f, cq1 = 0.f, ck0 = 0.f, ck1 = 0.f;
#pragma unroll
                for (int tp = 0; tp < 3; ++tp) { const int w = wc + tp - 1;
                    cq0 += cwq[tp][0] * bflo(rq[st][w]); cq1 += cwq[tp][1] * bfhi(rq[st][w]); ck0 += cwk[tp][0] * bflo(rk[st][w]); ck1 += cwk[tp][1] * bfhi(rk[st][w]); }
                run0 *= fg; run1 = run0;
                b0 = siluf(ck0); b1 = siluf(ck1); q0 = siluf(cq0) * 0.08838834764831845f; q1 = siluf(cq1) * 0.08838834764831845f;
                v0 = bflo(rv[st][k]) * ig; v1 = bfhi(rv[st][k]) * ig;
            }
            const float A0 = fmaxf(run0, 1e-30f), A1 = fmaxf(run1, 1e-30f);
            const float bh0 = b0 * __builtin_amdgcn_rcpf(A0), bh1 = b1 * __builtin_amdgcn_rcpf(A1);
            *(LAS unsigned*)(lds + MS_QT + (4 * wave + k) * MS_ROW + 4 * lane) = pk2(q0 * A0, q1 * A1);
            *(LAS unsigned*)(lds + MS_BT + (4 * wave + k) * MS_ROW + 4 * lane) = pk2(bh0, bh1);
            if (k & 1) { bt0[k >> 1] = pk2(bprev0, bh0); bt1[k >> 1] = pk2(bprev1, bh1); vt0[k >> 1] = pk2(vprev0, v0); vt1[k >> 1] = pk2(vprev1, v1); }
            else { bprev0 = bh0; bprev1 = bh1; vprev0 = v0; vprev1 = v1; }
        }
        *(LAS u32x2*)(lds + MS_BTT + (2 * lane) * MS_TROW + 8 * wave) = (u32x2){bt0[0], bt0[1]};
        *(LAS u32x2*)(lds + MS_BTT + (2 * lane + 1) * MS_TROW + 8 * wave) = (u32x2){bt1[0], bt1[1]};
        *(LAS u32x2*)(lds + MS_VT + (2 * lane) * MS_TROW + 8 * wave) = (u32x2){vt0[0], vt0[1]};
        *(LAS u32x2*)(lds + MS_VT + (2 * lane + 1) * MS_TROW + 8 * wave) = (u32x2){vt1[0], vt1[1]};
        if (wave == 7) *(LAS f32x2*)(AL + 2 * lane) = (f32x2){fmaxf(run0, 1e-30f), fmaxf(run1, 1e-30f)};
        if (BR == 1 && lane < 8 && !(lane & 1)) IV[4 * wave + (lane >> 1)] = gvec;
    };
    const std::integral_constant<int, 0> IC0{}; const std::integral_constant<int, 1> IC1{};
    f32x16 S[2];
#pragma unroll
    for (int k = 0; k < 2; ++k)
#pragma unroll
        for (int i = 0; i < 16; ++i) S[k][i] = 0.f;
    if (BR == 1 && tid < 128) { NV[tid] = 0.f; }
    if (tid < 128) XA[8 * 128 + tid] = 1.f;
    __syncthreads();
    issue(0, IC0); issue(1, IC1); part1(IC0);
    __syncthreads();
    part2(IC0);
    __builtin_amdgcn_sched_barrier(0);
    issue(2, IC0);
    __syncthreads();
    auto iter = [&](int ch, auto SETN) {
        const int nvc = (ch & 1) * 128, nvn = 128 - nvc;
        if (dh == 0) __builtin_amdgcn_s_setprio(2);
        f32x16 ot, ot2; float den = 0.f;
#pragma unroll
        for (int i = 0; i < 16; ++i) { ot[i] = 0.f; ot2[i] = 0.f; }
#pragma unroll
        for (int ks = 0; ks < 2; ++ks) {
            const bf16x8 qa = ld2x64(lds + MS_QT + r * MS_ROW + (32 * (2 * dh) + 16 * ks + 4 * hh) * 2), qb = ld2x64(lds + MS_QT + r * MS_ROW + (32 * (2 * dh + 1) + 16 * ks + 4 * hh) * 2);
            ot = MFMA32(pack8(S[0], ks), qa, ot); ot2 = MFMA32(pack8(S[1], ks), qb, ot2);
        }
        if (dh == 0) {
            f32x16 pt, pt2;
#pragma unroll
            for (int i = 0; i < 16; ++i) { pt[i] = 0.f; pt2[i] = 0.f; }
#pragma unroll
            for (int k = 0; k < 4; ++k) {
                const bf16x8 af = *(const LAS bf16x8*)(lds + MS_BT + r * MS_ROW + (16 * k + 8 * hh) * 2), bfr = *(const LAS bf16x8*)(lds + MS_QT + r * MS_ROW + (16 * k + 8 * hh) * 2);
                const bf16x8 af2 = *(const LAS bf16x8*)(lds + MS_BT + r * MS_ROW + (16 * (k + 4) + 8 * hh) * 2), bfr2 = *(const LAS bf16x8*)(lds + MS_QT + r * MS_ROW + (16 * (k + 4) + 8 * hh) * 2);
                pt = MFMA32(af, bfr, pt); pt2 = MFMA32(af2, bfr2, pt2); }
#pragma unroll
            for (int i = 0; i < 16; ++i) { const int sk = (i & 3) + 8 * (i >> 2) + 4 * hh; pt[i] = (sk <= r) ? pt[i] + pt2[i] : 0.f; }
            if (BR == 1) {
#pragma unroll
                for (int g4 = 0; g4 < 4; ++g4) { const f32x4 iv = *(const LAS f32x4*)(IV + 8 * g4 + 4 * hh); den += pt[4 * g4] * iv.x + pt[4 * g4 + 1] * iv.y + pt[4 * g4 + 2] * iv.z + pt[4 * g4 + 3] * iv.w; }
#pragma unroll 2
                for (int k = 0; k < 8; ++k) { const u32x4 qw = *(const LAS u32x4*)(lds + MS_QT + r * MS_ROW + (64 * hh + 8 * k) * 2);
                    const f32x4 n0 = *(const LAS f32x4*)(NV + nvc + 64 * hh + 8 * k), n1 = *(const LAS f32x4*)(NV + nvc + 64 * hh + 8 * k + 4);
                    den += bflo(qw.x) * n0.x + bfhi(qw.x) * n0.y + bflo(qw.y) * n0.z + bfhi(qw.y) * n0.w + bflo(qw.z) * n1.x + bfhi(qw.z) * n1.y + bflo(qw.w) * n1.z + bfhi(qw.w) * n1.w; }
                den += __shfl_xor(den, 32);
            }
#pragma unroll
            for (int ks = 0; ks < 2; ++ks) { const bf16x8 vf = ld2x64(lds + MS_VT + (32 * wv + r) * MS_TROW + (16 * ks + 4 * hh) * 2); ot = MFMA32(vf, pack8(pt, ks), ot); }
        }
#pragma unroll
        for (int i = 0; i < 16; ++i) ot[i] += ot2[i];
#pragma unroll
        for (int dj = 0; dj < 2; ++dj) { const int db = 2 * dh + dj;
#pragma unroll
            for (int ks = 0; ks < 2; ++ks) { const bf16x8 af = *(const LAS bf16x8*)(lds + MS_BTT + (32 * db + r) * MS_TROW + (16 * ks + 8 * hh) * 2), vf = *(const LAS bf16x8*)(lds + MS_VT + (32 * wv + r) * MS_TROW + (16 * ks + 8 * hh) * 2);
                S[dj] = MFMA32(af, vf, S[dj]); }
#pragma unroll
            for (int g4 = 0; g4 < 4; ++g4) { const f32x4 al = *(const LAS f32x4*)(AL + 32 * db + 8 * g4 + 4 * hh);
                S[dj][4 * g4] *= al.x; S[dj][4 * g4 + 1] *= al.y; S[dj][4 * g4 + 2] *= al.z; S[dj][4 * g4 + 3] *= al.w; }
        }
        __builtin_amdgcn_s_setprio(0);
        if (BR == 1 && wave >= 6) {
            const int d = 64 * (wave - 6) + lane; float ns = 0.f;
#pragma unroll 2
            for (int k = 0; k < 4; ++k) { const u32x4 bw = *(const LAS u32x4*)(lds + MS_BTT + d * MS_TROW + 16 * k); const f32x4 i0 = *(const LAS f32x4*)(IV + 8 * k), i1 = *(const LAS f32x4*)(IV + 8 * k + 4);
                ns += bflo(bw.x) * i0.x + bfhi(bw.x) * i0.y + bflo(bw.y) * i0.z + bfhi(bw.y) * i0.w + bflo(bw.z) * i1.x + bfhi(bw.z) * i1.y + bflo(bw.w) * i1.z + bfhi(bw.w) * i1.w; }
            NV[nvn + d] = AL[d] * (NV[nvc + d] + ns);
        }
        if (dh == 1) {
#pragma unroll
            for (int g4 = 0; g4 < 4; ++g4) *(LAS f32x4*)(XO + ((wv * 4 + g4) * 64 + lane) * 4) = (f32x4){ot[4 * g4], ot[4 * g4 + 1], ot[4 * g4 + 2], ot[4 * g4 + 3]};
        }
        __builtin_amdgcn_sched_barrier(0);
#if SCAN_XBAR
        __syncthreads();
#endif
        part1(SETN);
        if (SCAN_DUP & 1) part1(SETN);
        __syncthreads();
        for (int orep = 0; orep < ((SCAN_DUP & 8) ? 2 : 1); ++orep)
        if (dh == 0) {
            const int t = ch * ML + r; const size_t mrow = (size_t)(b * TT + tok_of(t));
            const float sc = (BR == 1) ? 1.f / fmaxf(fabsf(den), 1.f) : 1.f;
            bf16_t* op = Ob + mrow * 1024 + 32 * wv + 4 * hh;
#pragma unroll
            for (int gp2 = 0; gp2 < 4; gp2 += 2) {
            f32x4 pov[2];
#pragma unroll
            for (int g4 = 0; g4 < 2; ++g4) pov[g4] = *(const LAS f32x4*)(XO + ((wv * 4 + gp2 + g4) * 64 + lane) * 4);
#pragma unroll
            for (int g4i = 0; g4i < 2; ++g4i) { const int g4 = gp2 + g4i; const f32x4 po = pov[g4i];
                u32x2 w;
                if (BR == 1) { w.x = pk2((ot[4 * g4] + po.x) * sc, (ot[4 * g4 + 1] + po.y) * sc); w.y = pk2((ot[4 * g4 + 2] + po.z) * sc, (ot[4 * g4 + 3] + po.w) * sc); }
                else { w.x = pk2(ot[4 * g4] + po.x, ot[4 * g4 + 1] + po.y); w.y = pk2(ot[4 * g4 + 2] + po.z, ot[4 * g4 + 3] + po.w); }
                st_b64_untracked(op + 8 * g4, w); }
            }
        }
#if SCAN_XBAR
        __syncthreads();
#endif
        part2(SETN);
        if (SCAN_DUP & 2) part2(SETN);
        __builtin_amdgcn_sched_barrier(0);
        issue(ch + 3, SETN);
        if (SCAN_DUP & 16) { asm volatile("" ::: "memory"); issue(ch + 3, SETN); }
        __syncthreads();
    };
    for (int ch = 0; ch < MNCH; ch += 2) { iter(ch, IC1); iter(ch + 1, IC0); }
}

constexpr int KS_ROWB = 272, VT_ROWB = 72, KS_BYTES = 32 * KS_ROWB, VT_BYTES = 128 * VT_ROWB, AT_BUF = KS_BYTES + VT_BYTES;
template <bool LAT>
__device__ __forceinline__ void attn_unit(const Params& p, int layer, int b, int qg, int kvh, LAS unsigned char* lds) {
    const int tid = opaque_tid(), lane = tid & 63, wave = __builtin_amdgcn_readfirstlane(tid >> 6), r = lane & 31, hh = lane >> 5;
    const bf16_t* P = (const bf16_t*)(p.ws + WS_P);
    bf16_t* Y = (bf16_t*)(p.ws + WS_A);
    const float* tab = (const float*)(p.ws + WS_ROPE);
    const int head = kvh * 4 + (wave >> 1), qpos = qg * 64 + (wave & 1) * 32 + r;
    const int mq = b * TT + (LAT ? CTXL + qpos : qpos);
    bf16x8 qf[8];
    {
        const bf16_t* qp = P + (size_t)mq * NP + C_CQ + head * 128 + 8 * hh;
        const float scl = 0.08838834764831845f;
#pragma unroll
        for (int g = 0; g < 4; ++g) {
            const int s0 = (g & 1) + 4 * (g >> 1);
            const u32x4 ra = *(const u32x4*)(qp + 16 * s0), rb = *(const u32x4*)(qp + 16 * (s0 + 2));
            float xa[8] = {bflo(ra.x), bfhi(ra.x), bflo(ra.y), bfhi(ra.y), bflo(ra.z), bfhi(ra.z), bflo(ra.w), bfhi(ra.w)};
            float xb[8] = {bflo(rb.x), bfhi(rb.x), bflo(rb.y), bfhi(rb.y), bflo(rb.z), bfhi(rb.z), bflo(rb.w), bfhi(rb.w)};
            float oa[8], ob[8];
            if (LAT) {
                const int pos = (g < 2) ? (qpos >> 6) : (qpos & 63); const int i0 = 16 * (g & 1) + 8 * hh;
                const f32x4* tp = (const f32x4*)(tab + (size_t)(pos * 32 + i0) * 2);
#pragma unroll
                for (int jj = 0; jj < 4; ++jj) { const f32x4 cs = tp[jj];
                    oa[2 * jj] = xa[2 * jj] * cs.x - xb[2 * jj] * cs.y; ob[2 * jj] = xb[2 * jj] * cs.x + xa[2 * jj] * cs.y;
                    oa[2 * jj + 1] = xa[2 * jj + 1] * cs.z - xb[2 * jj + 1] * cs.w; ob[2 * jj + 1] = xb[2 * jj + 1] * cs.z + xa[2 * jj + 1] * cs.w; }
            } else {
#pragma unroll
                for (int j = 0; j < 8; ++j) { oa[j] = xa[j]; ob[j] = xb[j]; }
            }
            u32x4 wa, wb;
            wa.x = pk2(oa[0] * scl, oa[1] * scl); wa.y = pk2(oa[2] * scl, oa[3] * scl); wa.z = pk2(oa[4] * scl, oa[5] * scl); wa.w = pk2(oa[6] * scl, oa[7] * scl);
            wb.x = pk2(ob[0] * scl, ob[1] * scl); wb.y = pk2(ob[2] * scl, ob[3] * scl); wb.z = pk2(ob[4] * scl, ob[5] * scl); wb.w = pk2(ob[6] * scl, ob[7] * scl);
            qf[s0] = __builtin_bit_cast(bf16x8, wa); qf[s0 + 2] = __builtin_bit_cast(bf16x8, wb);
        }
    }
    const int skey = tid >> 4, sc = tid & 15;
    constexpr int NLAT = LAT ? 10 : 0, NT = NLAT + 8;
    u32x4 kraw, kprt, vraw; int kpos = 0; bool krope = false;
    auto issue = [&](int j) {
        int row;
        if (j < NLAT) { const int s = qg * 64 - 128 + 32 * j + skey; const int scl = s < 0 ? 0 : (s > SEQ - 1 ? SEQ - 1 : s); row = b * TT + CTXL + scl; kpos = scl; krope = true; }
        else { row = b * TT + 32 * (j - NLAT) + skey; krope = false; }
        const bf16_t* pr = P + (size_t)row * NP;
        kraw = *(const u32x4*)(pr + C_CK + kvh * 128 + 8 * sc);
        kprt = *(const u32x4*)(pr + C_CK + kvh * 128 + 8 * (sc ^ 4));
        vraw = *(const u32x4*)(pr + C_CV + kvh * 128 + 8 * sc);
    };
    auto stage = [&](int buf) {
        LAS unsigned char* ks = lds + buf * AT_BUF; LAS unsigned char* vt = ks + KS_BYTES;
        u32x4 kw = kraw;
        if (LAT && krope) {
            const float x[8] = {bflo(kraw.x), bfhi(kraw.x), bflo(kraw.y), bfhi(kraw.y), bflo(kraw.z), bfhi(kraw.z), bflo(kraw.w), bfhi(kraw.w)};
            const float y[8] = {bflo(kprt.x), bfhi(kprt.x), bflo(kprt.y), bfhi(kprt.y), bflo(kprt.z), bfhi(kprt.z), bflo(kprt.w), bfhi(kprt.w)};
            const int pos = (sc < 8) ? (kpos >> 6) : (kpos & 63); const int i0 = (8 * sc) & 31; const float sg = (sc & 4) ? 1.f : -1.f;
            const f32x4* tp = (const f32x4*)(tab + (size_t)(pos * 32 + i0) * 2);
            float o[8];
#pragma unroll
            for (int jj = 0; jj < 4; ++jj) { const f32x4 cs = tp[jj]; o[2 * jj] = x[2 * jj] * cs.x + sg * y[2 * jj] * cs.y; o[2 * jj + 1] = x[2 * jj + 1] * cs.z + sg * y[2 * jj + 1] * cs.w; }
            kw.x = pk2(o[0], o[1]); kw.y = pk2(o[2], o[3]); kw.z = pk2(o[4], o[5]); kw.w = pk2(o[6], o[7]);
        }
        *(LAS u32x4*)(ks + skey * KS_ROWB + sc * 16) = kw;
        LAS unsigned short* vp = (LAS unsigned short*)(vt + (8 * sc) * VT_ROWB + skey * 2);
        vp[0 * (VT_ROWB / 2)] = (unsigned short)(vraw.x & 0xffffu); vp[1 * (VT_ROWB / 2)] = (unsigned short)(vraw.x >> 16);
        vp[2 * (VT_ROWB / 2)] = (unsigned short)(vraw.y & 0xffffu); vp[3 * (VT_ROWB / 2)] = (unsigned short)(vraw.y >> 16);
        vp[4 * (VT_ROWB / 2)] = (unsigned short)(vraw.z & 0xffffu); vp[5 * (VT_ROWB / 2)] = (unsigned short)(vraw.z >> 16);
        vp[6 * (VT_ROWB / 2)] = (unsigned short)(vraw.w & 0xffffu); vp[7 * (VT_ROWB / 2)] = (unsigned short)(vraw.w >> 16);
    };
    f32x16 O[4];
#pragma unroll
    for (int k = 0; k < 4; ++k)
#pragma unroll
        for (int i = 0; i < 16; ++i) O[k][i] = 0.f;
    float mrun = p.in[12][layer * 8 + head], lrun = 1.f;
    __syncthreads();
    issue(0); stage(0);
    __syncthreads();
    for (int j = 0; j < NT; ++j) {
        const int buf = j & 1;
        if (j + 1 < NT) issue(j + 1);
        const LAS unsigned char* ks = lds + buf * AT_BUF; const LAS unsigned char* vt = ks + KS_BYTES;
        const int s0t = qg * 64 - 128 + 32 * j, rel = -128 + 32 * j - 32 * (wave & 1);
        const bool islat = LAT && j < NLAT;
        const bool skipt = islat && (rel <= -160 || rel >= 160 || s0t + 31 < 0 || s0t >= SEQ);
        const bool needmask = islat && !(rel >= -96 && rel <= 96 && s0t >= 0 && s0t + 31 < SEQ);
        if (!skipt) {
        f32x16 sa;
#pragma unroll
        for (int i = 0; i < 16; ++i) sa[i] = 0.f;
#pragma unroll
        for (int s = 0; s < 8; ++s) { const bf16x8 kf = *(const LAS bf16x8*)(ks + r * KS_ROWB + (16 * s + 8 * hh) * 2); sa = MFMA32(kf, qf[s], sa); }
        if (needmask) {
            const int s0 = qg * 64 - 128 + 32 * j + 4 * hh;
#pragma unroll
            for (int i = 0; i < 16; ++i) { const int sk = s0 + (i & 3) + 8 * (i >> 2); const int dd = qpos - sk; const bool ok = ((unsigned)sk < (unsigned)SEQ) && (dd <= 128) && (dd >= -128); sa[i] = ok ? sa[i] : -1e30f; }
        }
        float mx = sa[0];
#pragma unroll
        for (int i = 1; i < 16; ++i) mx = fmaxf(mx, sa[i]);
        mx = fmaxf(mx, __shfl_xor(mx, 32));
        const float mnew = fmaxf(mrun, mx), alpha = __expf(mrun - mnew);
        float ps = 0.f; float pv[16];
#pragma unroll
        for (int i = 0; i < 16; ++i) { pv[i] = __expf(sa[i] - mnew); ps += pv[i]; }
        ps += __shfl_xor(ps, 32);
        lrun = lrun * alpha + ps; mrun = mnew;
#pragma unroll
        for (int k = 0; k < 4; ++k)
#pragma unroll
            for (int i = 0; i < 16; ++i) O[k][i] *= alpha;
#pragma unroll
        for (int s = 0; s < 2; ++s) {
            u32x4 pw; pw.x = pk2(pv[8 * s], pv[8 * s + 1]); pw.y = pk2(pv[8 * s + 2], pv[8 * s + 3]); pw.z = pk2(pv[8 * s + 4], pv[8 * s + 5]); pw.w = pk2(pv[8 * s + 6], pv[8 * s + 7]);
            const bf16x8 pf = __builtin_bit_cast(bf16x8, pw);
#pragma unroll
            for (int k = 0; k < 4; ++k) {
                const LAS unsigned char* vr = vt + (32 * k + r) * VT_ROWB + (16 * s + 4 * hh) * 2;
                const u32x2 lo = *(const LAS u32x2*)(vr), hi = *(const LAS u32x2*)(vr + 16);
                u32x4 vw; vw.x = lo.x; vw.y = lo.y; vw.z = hi.x; vw.w = hi.y;
                O[k] = MFMA32(__builtin_bit_cast(bf16x8, vw), pf, O[k]);
            }
        }
        }
        if (j + 1 < NT) stage(buf ^ 1);
        __syncthreads();
    }
    const float inv = 1.f / lrun;
    const bf16_t* zp = P + (size_t)mq * NP + C_CZ + head * 128 + 4 * hh;
    bf16_t* yp = (bf16_t*)(p.ws + WS_P) + (size_t)mq * NP + C_CQ + head * 128 + 4 * hh;
    u32x2 zr[4][4];
#pragma unroll
    for (int k = 0; k < 4; ++k)
#pragma unroll
        for (int g = 0; g < 4; ++g) zr[k][g] = *(const u32x2*)(zp + 32 * k + 8 * g);
#pragma unroll
    for (int k = 0; k < 4; ++k)
#pragma unroll
        for (int g = 0; g < 4; ++g) {
            const u32x2 z = zr[k][g];
            const float o0 = O[k][4 * g] * inv * siluf(bflo(z.x)), o1 = O[k][4 * g + 1] * inv * siluf(bfhi(z.x)), o2 = O[k][4 * g + 2] * inv * siluf(bflo(z.y)), o3 = O[k][4 * g + 3] * inv * siluf(bfhi(z.y));
            u32x2 w; w.x = pk2(o0, o1); w.y = pk2(o2, o3);
            *(u32x2*)(yp + 32 * k + 8 * g) = w;
        }
}

__device__ __forceinline__ void mixer_phase(const Params& p, int layer, LAS unsigned char* lds) {
    const int G = (int)gridDim.x, bid = (int)blockIdx.x;
    const int nunits = 512 + (layer == 0 ? 32 : 0);
#if USE_VALU_SCAN == 1
    for (int u = bid; u < 256; u += G) { if (u < 128) scan_unit<0>(p, layer, u, lds); else scan_unit<1>(p, layer, u, lds); }
    const int a0 = bid, astep = G;
#elif USE_VALU_SCAN == 2
    if (bid < 32) scan_mfma<0>(p, layer, bid, lds); else if (bid < 160) scan_unit<1>(p, layer, 128 + bid - 32, lds);
    const int a0 = bid, astep = G;
#elif USE_VALU_SCAN == 3
    if (bid < 32) scan_mfma<1>(p, layer, 32 + bid, lds); else if (bid < 160) scan_unit<0>(p, layer, bid - 32, lds);
    const int a0 = bid, astep = G;
#else
    const bool split = G > 2 * SCAN_WGS;
    for (int rep = 0; rep < ((MIX_DUP & 3) ? 2 : 1); ++rep)
    for (int u = bid; u < 64; u += (split ? 64 : G)) { if (u < 32) { if (MIX_MASK & 1) scan_mfma<0>(p, layer, u, lds); } else { if (MIX_MASK & 2) scan_mfma<1>(p, layer, u, lds); } }
    if (split && bid >= SCAN_WGS) {
        const int na = G - SCAN_WGS;
        pg8::Gemm g{(const bf16_t*)(p.ws + WS_A), (const bf16_t*)(p.ws + WS_WIN) + (size_t)layer * NP * D + (size_t)NX * D, MROWS, NY1, D};
        pg8::StaticOrder S; S.init(MROWS, NY1, na, bid - SCAN_WGS);
        pg8::EpiP E{(bf16_t*)(p.ws + WS_P) + NX, NP};
        pg8::gemm_phase<pg8::EpiP, pg8::StaticOrder, true, true>(lds, g, S, E);
        unsigned* cnt = (unsigned*)(p.ws + WS_BAR) + layer * 64;
        asm volatile("s_waitcnt vmcnt(0)" ::: "memory");
        __syncthreads();
        if (threadIdx.x == 0) {
            __builtin_amdgcn_fence(__ATOMIC_RELEASE, "agent");
            asm volatile("s_waitcnt vmcnt(0)" ::: "memory");
            __hip_atomic_fetch_add(cnt, 1u, __ATOMIC_RELAXED, __HIP_MEMORY_SCOPE_AGENT);
            unsigned spins = 0;
            while (__hip_atomic_load(cnt, __ATOMIC_RELAXED, __HIP_MEMORY_SCOPE_AGENT) < (unsigned)na) { __builtin_amdgcn_s_sleep(2); if (++spins > (1u << 24)) break; }
            __builtin_amdgcn_fence(__ATOMIC_ACQUIRE, "agent");
            asm volatile("s_waitcnt vmcnt(0)" ::: "memory");
        }
        __syncthreads();
    }
    const int a0 = split ? (bid < SCAN_WGS ? nunits : bid - SCAN_WGS) : bid, astep = split ? G - SCAN_WGS : G;
#endif
    for (int rep = 0; rep < ((MIX_DUP & 4) ? 2 : 1); ++rep)
    if (MIX_MASK & 4) for (int u = a0; u < nunits; u += astep) {
        if (u < 512) attn_unit<true>(p, layer, u >> 7, (u & 127) >> 1, u & 1, lds);
        else { const int v = u - 512; attn_unit<false>(p, layer, (v >> 3) & 3, (v >> 1) & 3, v & 1, lds); }
    }
#if USE_VALU_SCAN == 0
    if (layer == 0 && split && bid >= SCAN_WGS) { __syncthreads(); weight_transposes(p, lds, 1, (bid - SCAN_WGS) * 8 + ((int)threadIdx.x >> 6), (G - SCAN_WGS) * 8); }
#endif
}

__device__ __forceinline__ void readout_phase(const Params& p, int layer) {
    const int tid = opaque_tid(), lane = tid & 63, wave = tid >> 6;
    const int gw = blockIdx.x * 8 + wave, NGW = gridDim.x * 8;
    const bf16_t* P = (const bf16_t*)(p.ws + WS_P);
    const bf16_t* Of = (const bf16_t*)(p.ws + WS_O); const bf16_t* Obk = Of + (size_t)MROWS * 1024;
    bf16_t* Y = (bf16_t*)(p.ws + WS_A);
    const int ch0 = lane * 16; const bool isb = lane >= 32;
    for (int m0 = gw; m0 < MROWS; m0 += 2 * NGW) {
        int mm[2]; bool act[2];
        u32x4 fr[2][2], br[2][2], gr[2][2], orr[2][2], cr[2][2];
#pragma unroll
        for (int q = 0; q < 2; ++q) {
            const int mq_ = m0 + q * NGW; const int m = mq_ < MROWS ? mq_ : MROWS - 1; mm[q] = m;
            act[q] = (mq_ < MROWS) && !(layer == 1 && (m % TT) < CTXL);
            fr[q][0] = *(const u32x4*)(Of + (size_t)m * 1024 + ch0); fr[q][1] = *(const u32x4*)(Of + (size_t)m * 1024 + ch0 + 8);
            br[q][0] = *(const u32x4*)(Obk + (size_t)m * 1024 + ch0); br[q][1] = *(const u32x4*)(Obk + (size_t)m * 1024 + ch0 + 8);
            const bf16_t* gp = P + (size_t)m * NP + (isb ? C_BZ + ch0 - 512 : C_AG + ch0);
            gr[q][0] = *(const u32x4*)(gp); gr[q][1] = *(const u32x4*)(gp + 8);
            const bf16_t* op = P + (size_t)m * NP + C_BO + (isb ? ch0 - 512 : ch0);
            orr[q][0] = *(const u32x4*)(op); orr[q][1] = *(const u32x4*)(op + 8);
            const bf16_t* cp = P + (size_t)m * NP + C_CQ + ch0;
            cr[q][0] = *(const u32x4*)(cp); cr[q][1] = *(const u32x4*)(cp + 8);
        }
#pragma unroll
        for (int q = 0; q < 2; ++q) {
            if (!act[q]) continue;
            const int m = mm[q];
            float y[16], g[16];
            const unsigned fw[8] = {fr[q][0].x, fr[q][0].y, fr[q][0].z, fr[q][0].w, fr[q][1].x, fr[q][1].y, fr[q][1].z, fr[q][1].w};
            const unsigned bw[8] = {br[q][0].x, br[q][0].y, br[q][0].z, br[q][0].w, br[q][1].x, br[q][1].y, br[q][1].z, br[q][1].w};
            const unsigned gw8[8] = {gr[q][0].x, gr[q][0].y, gr[q][0].z, gr[q][0].w, gr[q][1].x, gr[q][1].y, gr[q][1].z, gr[q][1].w};
#pragma unroll
            for (int e = 0; e < 8; ++e) { y[2 * e] = bflo(fw[e]) + bflo(bw[e]); y[2 * e + 1] = bfhi(fw[e]) + bfhi(bw[e]); g[2 * e] = bflo(gw8[e]); g[2 * e + 1] = bfhi(gw8[e]); }
            if (isb) {
                const unsigned ow[8] = {orr[q][0].x, orr[q][0].y, orr[q][0].z, orr[q][0].w, orr[q][1].x, orr[q][1].y, orr[q][1].z, orr[q][1].w};
#pragma unroll
                for (int e = 0; e < 8; ++e) { y[2 * e] *= sigm(bflo(ow[e])); y[2 * e + 1] *= sigm(bfhi(ow[e])); }
            }
            float ss = 0.f;
#pragma unroll
            for (int e = 0; e < 16; ++e) ss += y[e] * y[e];
            ss += __shfl_xor(ss, 1); ss += __shfl_xor(ss, 2); ss += __shfl_xor(ss, 4);
            const float rs = __builtin_amdgcn_rsqf(ss * (1.f / 128.f) + EPS);
            u32x4 w0, w1; unsigned ww[8];
#pragma unroll
            for (int e = 0; e < 8; ++e) ww[e] = pk2(y[2 * e] * rs * siluf(g[2 * e]), y[2 * e + 1] * rs * siluf(g[2 * e + 1]));
            w0.x = ww[0]; w0.y = ww[1]; w0.z = ww[2]; w0.w = ww[3]; w1.x = ww[4]; w1.y = ww[5]; w1.z = ww[6]; w1.w = ww[7];
            *(u32x4*)(Y + (size_t)m * D + ch0) = w0; *(u32x4*)(Y + (size_t)m * D + ch0 + 8) = w1;
            *(u32x4*)(Y + (size_t)m * D + 1024 + ch0) = cr[q][0]; *(u32x4*)(Y + (size_t)m * D + 1024 + ch0 + 8) = cr[q][1];
        }
    }
}

#define XB_TMO      128
#define XB_XCNT(j)  (256  + 64 * (j))
#define XB_XSUB(j)  (1280 + 64 * (j))
#define XB_XGEN(j)  (2304 + 64 * (j))
#define XB_TOP      3328
#define XB_TOPGEN   3392
#define XCD_BAR_WORDS 3456
#define XB_SPIN_CAP (1u << 18)

__device__ __forceinline__ unsigned xb_ld(unsigned* p)              { return __hip_atomic_load(p, __ATOMIC_RELAXED, __HIP_MEMORY_SCOPE_AGENT); }
__device__ __forceinline__ unsigned xb_add(unsigned* p, unsigned v) { return __hip_atomic_fetch_add(p, v, __ATOMIC_RELAXED, __HIP_MEMORY_SCOPE_AGENT); }
__device__ __forceinline__ unsigned xb_xcc_id() { return (unsigned)__builtin_amdgcn_s_getreg((3 << 11) | 20) & 0xFu; }
#define XB_SPIN(cond, bar) do { unsigned _sp = 0; while (cond) { __builtin_amdgcn_s_sleep(1); \
    if ((++_sp & 255u) == 0u) { if (xb_ld(&(bar)[XB_TMO])) break; if (_sp > XB_SPIN_CAP) { atomicAdd(&(bar)[XB_TMO], 1u); break; } } } } while (0)

struct XcdBarrier {
    unsigned* bar; unsigned x;
    volatile LAS unsigned* st;
};

__device__ __forceinline__ XcdBarrier xcd_barrier_post(unsigned* bar, volatile LAS unsigned* st) {
    XcdBarrier b; b.bar = bar; b.x = xb_xcc_id(); b.st = st;
    if (threadIdx.x == 0) (void)xb_add(&bar[XB_XCNT(b.x)], 1u);
    return b;
}
__device__ __forceinline__ void xcd_barrier_complete(unsigned* bar, unsigned x, unsigned& nloc, unsigned& nx) {
    const unsigned G = gridDim.x * gridDim.y * gridDim.z;
    unsigned sum, cnt, mine, sp = 0u;
    for (;;) {
        sum = 0u; cnt = 0u; mine = 0u;
#pragma unroll
        for (unsigned j = 0; j < 16; ++j) { const unsigned c = xb_ld(&bar[XB_XCNT(j)]); sum += c; cnt += (c > 0u) ? 1u : 0u; mine = (j == x) ? c : mine; }
        if (sum == G) break;
        __builtin_amdgcn_s_sleep(1);
        if ((++sp & 255u) == 0u) { if (xb_ld(&bar[XB_TMO])) break; if (sp > XB_SPIN_CAP) { atomicAdd(&bar[XB_TMO], 1u); break; } }
    }
    nloc = mine > 0u ? mine : 1u; nx = cnt > 0u ? cnt : 1u;
}

__device__ __forceinline__ void xcd_barrier(const XcdBarrier& b) {
    asm volatile("s_waitcnt vmcnt(0)" ::: "memory");
    __syncthreads();
    if (threadIdx.x == 0) {
        unsigned* bar = b.bar;
        __builtin_amdgcn_s_waitcnt(0);
        unsigned nloc = b.st[0], nx = b.st[1];
        if (nloc == 0u) { xcd_barrier_complete(bar, b.x, nloc, nx); b.st[0] = nloc; b.st[1] = nx; }
        const unsigned old = xb_add(&bar[XB_XSUB(b.x)], 1u);
        const unsigned gen = old / nloc;
        if (old + 1u == (gen + 1u) * nloc) {
            __builtin_amdgcn_fence(__ATOMIC_RELEASE, "agent");
            asm volatile("s_waitcnt vmcnt(0)" ::: "memory");
            const unsigned og = xb_add(&bar[XB_TOP], 1u);
            const unsigned tg = og / nx;
            if (og + 1u == (tg + 1u) * nx) xb_add(&bar[XB_TOPGEN], 1u);
            else XB_SPIN(xb_ld(&bar[XB_TOPGEN]) == tg, bar);
            __builtin_amdgcn_fence(__ATOMIC_ACQUIRE, "agent");
            xb_add(&bar[XB_XGEN(b.x)], 1u);
            asm volatile("s_waitcnt vmcnt(0)" ::: "memory");
        } else {
            XB_SPIN(xb_ld(&bar[XB_XGEN(b.x)]) == gen, bar);
            __builtin_amdgcn_fence(__ATOMIC_ACQUIRE, "agent");
            asm volatile("s_waitcnt vmcnt(0)" ::: "memory");
        }
    }
    __syncthreads();
}

__global__ void __launch_bounds__(512, 2) mega_fwd(Params p) {
    extern __shared__ __attribute__((aligned(16))) unsigned char lds_raw[];
    LAS unsigned char* lds = (LAS unsigned char*)lds_raw;
    cg::grid_group grid = cg::this_grid();
    volatile LAS unsigned* xst = (volatile LAS unsigned*)(lds + 131072);
    if (threadIdx.x < 2) xst[threadIdx.x] = 0u;
    __syncthreads();
    XcdBarrier xbar = xcd_barrier_post((unsigned*)(p.ws + WS_XBAR), xst);
    for (int ph = p.ph_lo; ph < p.ph_hi; ++ph) {
        int nrep = 1;
        if (DUP_MASK != 0 && ph >= 2 && ((DUP_MASK >> ((ph - 2) % 5)) & 1)) nrep = 2;
        for (int rep = 0; rep < nrep; ++rep) {
        if (ph == 0) { if (PH_MASK & 1) p0_prologue(p, lds); }
        else if (ph == 1) { if (PH_MASK & 2) row_phase<0>(p); }
        else {
            const int layer = (ph - 2) / 5, sub = (ph - 2) % 5;
            if (sub == 0) { if (PH_MASK & 4) {
                const int nfirst = ((int)gridDim.x > 2 * SCAN_WGS) ? NX : NP;
                pg8::Gemm g{(const bf16_t*)(p.ws + WS_A), (const bf16_t*)(p.ws + WS_WIN) + (size_t)layer * NP * D, MROWS, nfirst, D};
                pg8::StaticOrder S; S.init(MROWS, nfirst, (int)gridDim.x, (int)blockIdx.x);
                pg8::EpiP E{(bf16_t*)(p.ws + WS_P), NP};
                pg8::gemm_phase<pg8::EpiP, pg8::StaticOrder, true, true>(lds, g, S, E); }
            } else if (sub == 1) { if (PH_MASK & 8) mixer_phase(p, layer, lds); }
            else if (sub == 2) { if (PH_MASK & 16) readout_phase(p, layer); }
            else if (sub == 3) { if (PH_MASK & 32) {
                pg8::Gemm g{(const bf16_t*)(p.ws + WS_A), (const bf16_t*)(p.ws + WS_WOUT) + (size_t)layer * D * D, MROWS, D, D};
                pg8::EpiP E{(bf16_t*)(p.ws + WS_P), D};
                if (layer == 0) { pg8::StaticOrder S; S.init(MROWS, D, (int)gridDim.x, (int)blockIdx.x); pg8::gemm_phase<pg8::EpiP, pg8::StaticOrder, true, true>(lds, g, S, E); }
                else { pg8::LatentOrder S; S.init(NBATCH * SEQ, D, (int)gridDim.x, (int)blockIdx.x); pg8::gemm_phase<pg8::EpiP, pg8::LatentOrder, true, true>(lds, g, S, E); } }
            } else { if (PH_MASK & 64) { if (layer == 0) row_phase<1>(p); else row_phase<2>(p); } }
        }
        }
        if (ph + 1 < p.ph_hi) { if (p.ph_hi > NPHASE) grid.sync(); else xcd_barrier(xbar); }
    }
}

#ifndef MK_PER_PHASE
#define MK_PER_PHASE 0
#endif
extern "C" void kernel_launch(void* const* d_in, const int* in_sizes, int n_in, void* d_out, int out_size, void* d_ws, size_t ws_size, hipStream_t stream) {
    static int grid = 0;
    if (grid == 0) {
        if (n_in != 14 || ws_size < WS_END) { fprintf(stderr, "kernel_launch: unexpected inputs (n_in %d, ws %zu < %zu)\n", n_in, ws_size, (size_t)WS_END); grid = -1; return; }
        int dev = 0, cus = 0, per_cu = 0;
        hipGetDevice(&dev); hipDeviceGetAttribute(&cus, hipDeviceAttributeMultiprocessorCount, dev);
        if (hipFuncSetAttribute((const void*)mega_fwd, hipFuncAttributeMaxDynamicSharedMemorySize, LDS_BYTES) != hipSuccess) { fprintf(stderr, "kernel_launch: hipFuncSetAttribute failed\n"); grid = -1; return; }
        if (hipOccupancyMaxActiveBlocksPerMultiprocessor(&per_cu, (const void*)mega_fwd, 512, LDS_BYTES) != hipSuccess || per_cu < 1) { fprintf(stderr, "kernel_launch: occupancy query says %d\n", per_cu); per_cu = 1; }
        (void)hipGetLastError();
        grid = cus * (per_cu > 1 ? 1 : per_cu);
        if (grid > 256) grid = 256;
    }
    if (grid < 0) return;
    (void)hipMemsetAsync((char*)d_ws + WS_MOD, 0, (size_t)2 * 5 * NMOD * 4 + 1024 + 16384, stream);
    Params p{};
    for (int i = 0; i < 14; ++i) p.in[i] = (const float*)d_in[i];
    p.out = (float*)d_out; p.ws = (unsigned char*)d_ws;
#if MK_PER_PHASE
    for (int ph = 0; ph < NPHASE; ++ph) { p.ph_lo = ph; p.ph_hi = ph + 1; hipLaunchKernelGGL(mega_fwd, dim3(grid), dim3(512), LDS_BYTES, stream, p); }
#else
    p.ph_lo = 0; p.ph_hi = NPHASE;
    void* args[] = {&p};
    hipError_t e = hipLaunchCooperativeKernel((const void*)mega_fwd, dim3(grid), dim3(512), args, LDS_BYTES, stream);
    if (e != hipSuccess) fprintf(stderr, "cooperative launch failed: %s (grid %d)\n", hipGetErrorString(e), grid);
#endif
}
```

```cpp
#include <hip/hip_runtime.h>
#include <hip/hip_cooperative_groups.h>
#include <cstdio>
#include <cstdint>
#include <type_traits>
namespace cg = cooperative_groups;
__device__ __forceinline__ int opaque_tid() { int t = threadIdx.x; asm volatile("" : "+v"(t)); return t; }
__device__ __forceinline__ int opaque_bid() { int t = blockIdx.x; asm volatile("" : "+s"(t)); return t; }
#define MK_PER_PHASE 0
namespace pg8 {
#define PG8_LAS __attribute__((address_space(3)))
typedef unsigned short bf16_t;
typedef short bf16x8 __attribute__((ext_vector_type(8)));
typedef float f32x4 __attribute__((ext_vector_type(4)));
typedef unsigned u32x4 __attribute__((ext_vector_type(4)));
constexpr int BM = 256, BK = 64, HALF = 128, HTB = HALF * BK * 2  , STAGE_BYTES = 8 * HTB, NXCD = 8, WGM = 8;

__host__ __device__ __forceinline__ int lds_byte(int r, int c) { const int st = (r >> 4) * 2 + (c >> 5), rr = r & 15, cc = c & 31, ob = rr * 64 + cc * 2; return st * 1024 + (ob ^ (((ob >> 9) & 1) << 5)); }
__host__ __device__ __forceinline__ void stage_rc(int b, int& R, int& C) { const int st = b / 1024, sb = b % 1024, swz = sb ^ (((sb >> 9) & 1) << 5); R = (st >> 1) * 16 + swz / 64; C = (st & 1) * 32 + (swz % 64) / 2; }
__host__ __device__ __forceinline__ int perm32(int rho) { const int n = rho >> 4, i = rho & 15; return 8 * (i >> 2) + 4 * n + (i & 3); }

struct Unit { int pm, pn; };
struct Gemm { const bf16_t* A; const bf16_t* Bt; int M, N, K; };

struct StaticOrder {
    int nM, nN, nwg, G, c;
    __host__ __device__ void init(int M, int N, int G_, int c_) { nM = M / BM; nN = N / BM; nwg = nM * nN; G = G_; c = c_; }
    __host__ __device__ bool next(int i, Unit& u) const {
        const long L = (long)i * G + c; if (L >= nwg) return false;
        int wgid = (int)L; { const int q = nwg / NXCD, r = nwg % NXCD, xcd = wgid % NXCD, off = wgid / NXCD; wgid = (xcd < r ? xcd * (q + 1) : r * (q + 1) + (xcd - r) * q) + off; }
        const int nig = WGM * nN, gid = wgid / nig, fm = gid * WGM, gsz = (nM - fm) < WGM ? (nM - fm) : WGM;
        u.pm = fm + ((wgid % nig) % gsz); u.pn = (wgid % nig) / gsz; return true;
    }
    __device__ __forceinline__ void a_ready(const Unit&) const {}
    __device__ __forceinline__ void done(const Unit&) const {}
};

__device__ __forceinline__ unsigned cvt_pk_bf16(float lo, float hi) { unsigned r; asm volatile("v_cvt_pk_bf16_f32 %0, %1, %2" : "=v"(r) : "v"(lo), "v"(hi)); return r; }
typedef float f32x2 __attribute__((ext_vector_type(2)));
template <class Epi, class Sched, bool ALIGN_EPI = false, bool SP2 = false>
__device__ __forceinline__ void gemm_phase(PG8_LAS unsigned char* lds, const Gemm g, const Sched& S, const Epi& E) {
    const int tid = opaque_tid(), wid = __builtin_amdgcn_readfirstlane(tid >> 6), lane = tid & 63, wr = wid >> 2, wc = wid & 3, fr = lane & 15, fq = lane >> 4;
    const int K = g.K, nt = K / BK;
    unsigned voffA[2], voffB[2];
#pragma unroll
    for (int i = 0; i < 2; ++i) { int R, C; stage_rc(tid * 16 + i * 8192, R, C); const int Rb = Epi::PERM ? ((R & ~31) + perm32(R & 31)) : R;
        voffA[i] = (unsigned)(R * K + C) * 2u; voffB[i] = (unsigned)(Rb * K + C) * 2u; }
    const size_t kstep = (size_t)(BK * 2);
    const size_t hstep = (size_t)HALF * K * 2;
    const size_t tstep = 2 * hstep;
    const unsigned ldsw = (unsigned)wid * 1024u;
    const int aoff = lds_byte(wr * 64 + fr, fq * 8), boff = lds_byte(wc * 32 + fr, fq * 8);
#define PG8_SA(b, h) (((b) * 2 + (h)) * HTB)
#define PG8_SB(b, h) ((4 + (b) * 2 + (h)) * HTB)
#define PG8_STAGE(bufoff, gbase, voff) do { _Pragma("unroll") for (int _i = 0; _i < 2; ++_i) \
        __builtin_amdgcn_global_load_lds((const unsigned*)((const char*)(gbase) + (voff)[_i]), (PG8_LAS unsigned*)(lds + (bufoff) + ldsw + _i * 8192), 16, 0, 0); } while (0)
#define PG8_LDA(dst, b, h) do { _Pragma("unroll") for (int m = 0; m < 4; ++m) _Pragma("unroll") for (int k = 0; k < 2; ++k) dst[m][k] = *(const PG8_LAS bf16x8*)(lds + PG8_SA(b, h) + aoff + m * 2048 + k * 1024); } while (0)
#define PG8_LDB(dst, b, h) do { _Pragma("unroll") for (int n = 0; n < 2; ++n) _Pragma("unroll") for (int k = 0; k < 2; ++k) dst[n][k] = *(const PG8_LAS bf16x8*)(lds + PG8_SB(b, h) + boff + n * 2048 + k * 1024); } while (0)
#define PG8_MMA(ai, bj, At, Bt) do { __builtin_amdgcn_s_setprio(1); _Pragma("unroll") for (int m = 0; m < 4; ++m) _Pragma("unroll") for (int n = 0; n < 2; ++n) _Pragma("unroll") for (int k = 0; k < 2; ++k) \
        acc[ai][bj][m][n] = __builtin_amdgcn_mfma_f32_16x16x32_bf16(Bt[n][k], At[m][k], acc[ai][bj][m][n], 0, 0, 0); __builtin_amdgcn_s_setprio(0); } while (0)
#define PG8_WAIT_V(n) asm volatile("s_waitcnt vmcnt(" #n ")" ::: "memory")
#define PG8_WAIT_L(n) asm volatile("s_waitcnt lgkmcnt(" #n ")" ::: "memory")
#define PG8_BAR __builtin_amdgcn_s_barrier()
#define PG8_SCHED __builtin_amdgcn_sched_barrier(0)
    Unit cur, nxt; int ui = 0;
    if (!S.next(0, cur)) return;
    f32x4 acc[2][2][4][2];
#pragma unroll
    for (int a = 0; a < 2; ++a)
#pragma unroll
        for (int b = 0; b < 2; ++b)
#pragma unroll
            for (int m = 0; m < 4; ++m)
#pragma unroll
                for (int n = 0; n < 2; ++n) acc[a][b][m][n] = (f32x4){0.f, 0.f, 0.f, 0.f};
    bf16x8 At[4][2], B0[2][2], B1[2][2];
    const char* cA = (const char*)g.A + (size_t)cur.pm * tstep; const char* cB = (const char*)g.Bt + (size_t)cur.pn * tstep;
    S.a_ready(cur);
    if constexpr (SP2) {
        PG8_STAGE(PG8_SB(0, 0), cB, voffB); PG8_STAGE(PG8_SB(0, 1), cB + hstep, voffB); PG8_STAGE(PG8_SA(0, 0), cA, voffA); PG8_STAGE(PG8_SA(0, 1), cA + hstep, voffA);
        if (wr == 1) PG8_BAR;
        PG8_WAIT_V(2); PG8_BAR;
        PG8_STAGE(PG8_SB(1, 0), cB + kstep, voffB); PG8_STAGE(PG8_SA(1, 0), cA + kstep, voffA); PG8_STAGE(PG8_SB(1, 1), cB + hstep + kstep, voffB);
        PG8_WAIT_V(6); PG8_BAR;
    } else {
        PG8_STAGE(PG8_SB(0, 0), cB, voffB); PG8_STAGE(PG8_SA(0, 0), cA, voffA); PG8_STAGE(PG8_SB(0, 1), cB + hstep, voffB); PG8_STAGE(PG8_SA(0, 1), cA + hstep, voffA);
        if (wr == 1) PG8_BAR;
        PG8_WAIT_V(4); PG8_BAR;
        PG8_STAGE(PG8_SB(1, 0), cB + kstep, voffB); PG8_STAGE(PG8_SA(1, 0), cA + kstep, voffA); PG8_STAGE(PG8_SB(1, 1), cB + hstep + kstep, voffB);
        PG8_WAIT_V(6); PG8_BAR;
    }
    for (;;) {
        const bool has_next = S.next(ui + 1, nxt);
        const char* nA = has_next ? (const char*)g.A + (size_t)nxt.pm * tstep : cA; const char* nB = has_next ? (const char*)g.Bt + (size_t)nxt.pn * tstep : cB;
        for (int t = 0; t < nt; t += 2) {
            const bool last = (t == nt - 2);
            const char* a1 = cA + (size_t)(t + 1) * kstep;
            const char* a2 = last ? nA : cA + (size_t)(t + 2) * kstep; const char* b2 = last ? nB : cB + (size_t)(t + 2) * kstep;
            const char* a3 = a2 + kstep; const char* b3 = b2 + kstep;
            if (last && has_next) S.a_ready(nxt);
            if constexpr (SP2) {
            PG8_LDB(B0, 0, 0); PG8_LDB(B1, 0, 1); PG8_SCHED; PG8_LDA(At, 0, 0); PG8_STAGE(PG8_SA(1, 1), a1 + hstep, voffA);
            PG8_WAIT_V(8); PG8_WAIT_L(0); PG8_BAR; PG8_MMA(0, 0, At, B0); PG8_MMA(0, 1, At, B1); PG8_BAR; PG8_SCHED;
            PG8_LDA(At, 0, 1); PG8_STAGE(PG8_SB(0, 0), b2, voffB); PG8_STAGE(PG8_SB(0, 1), b2 + hstep, voffB); PG8_STAGE(PG8_SA(0, 0), a2, voffA);
            PG8_WAIT_V(8); PG8_WAIT_L(0); PG8_BAR; PG8_MMA(1, 0, At, B0); PG8_MMA(1, 1, At, B1); PG8_BAR; PG8_SCHED;
            PG8_LDB(B0, 1, 0); PG8_LDB(B1, 1, 1); PG8_SCHED; PG8_LDA(At, 1, 0); PG8_STAGE(PG8_SA(0, 1), a2 + hstep, voffA);
            PG8_WAIT_V(8); PG8_WAIT_L(0); PG8_BAR; PG8_MMA(0, 0, At, B0); PG8_MMA(0, 1, At, B1); PG8_BAR; PG8_SCHED;
            PG8_LDA(At, 1, 1); PG8_STAGE(PG8_SB(1, 0), b3, voffB); PG8_STAGE(PG8_SB(1, 1), b3 + hstep, voffB); PG8_STAGE(PG8_SA(1, 0), a3, voffA);
            PG8_WAIT_V(8); PG8_WAIT_L(0); PG8_BAR; PG8_MMA(1, 0, At, B0); PG8_MMA(1, 1, At, B1); PG8_BAR; PG8_SCHED;
            } else {
            PG8_LDB(B0, 0, 0); PG8_SCHED; PG8_LDA(At, 0, 0); PG8_STAGE(PG8_SA(1, 1), a1 + hstep, voffA);
            PG8_WAIT_L(8); PG8_BAR; PG8_WAIT_L(0); PG8_MMA(0, 0, At, B0); PG8_BAR; PG8_SCHED;
            PG8_LDB(B1, 0, 1); PG8_STAGE(PG8_SB(0, 0), b2, voffB);
            PG8_BAR; PG8_WAIT_L(0); PG8_MMA(0, 1, At, B1); PG8_BAR;
            PG8_LDA(At, 0, 1); PG8_STAGE(PG8_SA(0, 0), a2, voffA);
            PG8_BAR; PG8_WAIT_L(0); PG8_MMA(1, 0, At, B0); PG8_BAR; PG8_SCHED;
            PG8_STAGE(PG8_SB(0, 1), b2 + hstep, voffB);
            PG8_WAIT_V(6); PG8_BAR; PG8_MMA(1, 1, At, B1); PG8_BAR;
            PG8_LDB(B0, 1, 0); PG8_SCHED; PG8_LDA(At, 1, 0); PG8_STAGE(PG8_SA(0, 1), a2 + hstep, voffA);
            PG8_WAIT_L(8); PG8_BAR; PG8_WAIT_L(0); PG8_MMA(0, 0, At, B0); PG8_BAR; PG8_SCHED;
            PG8_LDB(B1, 1, 1); PG8_STAGE(PG8_SB(1, 0), b3, voffB);
            PG8_BAR; PG8_WAIT_L(0); PG8_MMA(0, 1, At, B1); PG8_BAR;
            PG8_LDA(At, 1, 1); PG8_STAGE(PG8_SA(1, 0), a3, voffA);
            PG8_BAR; PG8_WAIT_L(0); PG8_MMA(1, 0, At, B0); PG8_BAR; PG8_SCHED;
            PG8_STAGE(PG8_SB(1, 1), b3 + hstep, voffB);
            PG8_WAIT_V(6); PG8_BAR; PG8_MMA(1, 1, At, B1); PG8_BAR;
            }
        }
        if constexpr (ALIGN_EPI) { if (wr == 0) PG8_BAR; }
        if constexpr (!Epi::AFTER_DRAIN) { E(acc, cur, wr, wc, fr, fq); S.done(cur); }
        if (!has_next) break;
#pragma unroll
        for (int a = 0; a < 2; ++a)
#pragma unroll
            for (int b = 0; b < 2; ++b)
#pragma unroll
                for (int m = 0; m < 4; ++m)
#pragma unroll
                    for (int n = 0; n < 2; ++n) acc[a][b][m][n] = (f32x4){0.f, 0.f, 0.f, 0.f};
        cur = nxt; cA = nA; cB = nB; ++ui;
        if constexpr (ALIGN_EPI) { if (wr == 1) PG8_BAR; }
    }
    PG8_WAIT_V(0);
    if constexpr (!ALIGN_EPI) { if (wr == 0) PG8_BAR; }
    PG8_BAR;
    if constexpr (Epi::AFTER_DRAIN) { E.fused(acc, cur, wr, wc, fr, fq, lds, wid, lane); S.done(cur); }
#undef PG8_SA
#undef PG8_SB
#undef PG8_STAGE
#undef PG8_LDA
#undef PG8_LDB
#undef PG8_MMA
#undef PG8_WAIT_V
#undef PG8_WAIT_L
#undef PG8_BAR
#undef PG8_SCHED
}
}
namespace pg8 {
struct EpiP {
    static constexpr bool PERM = true, AFTER_DRAIN = false;
    bf16_t* O; int ldc;
    __device__ __forceinline__ void operator()(const f32x4 (&acc)[2][2][4][2], const Unit& u, int wr, int wc, int fr, int fq) const {
        const int row0 = u.pm * BM + wr * 64 + fr; const int col0 = u.pn * BM + wc * 32 + 8 * fq;
#pragma unroll
        for (int ai = 0; ai < 2; ++ai)
#pragma unroll
            for (int m = 0; m < 4; ++m) { bf16_t* rowp = O + (size_t)(row0 + ai * HALF + m * 16) * ldc + col0;
#pragma unroll
                for (int bj = 0; bj < 2; ++bj) { const f32x4 v0 = acc[ai][bj][m][0], v1 = acc[ai][bj][m][1];
                    u32x4 w; w.x = cvt_pk_bf16(v0[0], v0[1]); w.y = cvt_pk_bf16(v0[2], v0[3]); w.z = cvt_pk_bf16(v1[0], v1[1]); w.w = cvt_pk_bf16(v1[2], v1[3]);
                    *(u32x4*)(rowp + bj * HALF) = w; } }
    }
};
struct EpiY {
    static constexpr bool PERM = false, AFTER_DRAIN = false;
    float* C; int ldc;
    __device__ __forceinline__ void operator()(const f32x4 (&acc)[2][2][4][2], const Unit& u, int wr, int wc, int fr, int fq) const {
        const int row0 = u.pm * BM + wr * 64 + fr, col0 = u.pn * BM + wc * 32 + 4 * fq;
#pragma unroll
        for (int ai = 0; ai < 2; ++ai)
#pragma unroll
            for (int m = 0; m < 4; ++m) { float* rowp = C + (size_t)(row0 + ai * HALF + m * 16) * ldc + col0;
#pragma unroll
                for (int bj = 0; bj < 2; ++bj)
#pragma unroll
                    for (int n = 0; n < 2; ++n) *(f32x4*)(rowp + bj * HALF + n * 16) = acc[ai][bj][m][n]; }
    }
};
struct LatentOrder : StaticOrder {
    __host__ __device__ bool next(int i, Unit& u) const { if (!StaticOrder::next(i, u)) return false; u.pm = u.pm + u.pm / 16 + 1; return true; }
};
}

#ifndef PH_MASK
#define PH_MASK 0xfff
#endif
#ifndef DUP_MASK
#define DUP_MASK 0
#endif
#ifndef MIX_DUP
#define MIX_DUP 0
#endif
#ifndef USE_VALU_SCAN
#define USE_VALU_SCAN 0
#endif
#ifndef SCAN_DUP
#define SCAN_DUP 0
#endif
#ifndef SCAN_XBAR
#define SCAN_XBAR 0
#endif
#ifndef MIX_MASK
#define MIX_MASK 7
#endif
using pg8::bf16_t; using pg8::bf16x8; using pg8::f32x4; using pg8::u32x4;
typedef float f32x2 __attribute__((ext_vector_type(2)));
typedef float f32x16 __attribute__((ext_vector_type(16)));
typedef unsigned u32x2 __attribute__((ext_vector_type(2)));
#define LAS __attribute__((address_space(3)))

constexpr int D = 2048, NBATCH = 4, SEQ = 4096, CTXL = 256, TT = SEQ + CTXL, MROWS = NBATCH * TT;
constexpr int NPW = 7696, NP = 7936, NMOD = 6144;
constexpr float EPS = 1e-6f;
constexpr int C_AQ = 0, C_AFF = 512, C_AFB = 1024, C_AI = 1536, C_BQ = 2048, C_BK = 2560, C_BV = 3072, C_GT = 3584,
              C_CQ = 3840, C_CK = 4864, C_CV = 5120, C_CZ = 5376, C_AG = 6400, C_BO = 6912, C_BZ = 7424;
constexpr int NX = 15 * 256, NY1 = NP - NX, SCAN_WGS = 64;
constexpr size_t WS_WIN  = 0;
constexpr size_t WS_WOUT = WS_WIN  + (size_t)2 * NP * D * 2;
constexpr size_t WS_A    = WS_WOUT + (size_t)2 * D * D * 2;
constexpr size_t WS_P    = WS_A    + (size_t)MROWS * D * 2;
constexpr size_t WS_HCTX = WS_P    + (size_t)MROWS * NP * 2;
constexpr size_t WS_O    = WS_HCTX + (size_t)NBATCH * CTXL * D * 4;
constexpr size_t WS_MOD  = WS_O    + (size_t)2 * MROWS * 1024 * 2;
constexpr size_t WS_BAR  = WS_MOD  + (size_t)2 * 5 * NMOD * 4;
constexpr size_t WS_XBAR = WS_BAR + 1024;
constexpr size_t WS_ROPE = WS_XBAR + 16384;
constexpr size_t WS_END  = WS_ROPE + (size_t)64 * 32 * 8;
constexpr int LDS_BYTES = 131072 + 64;
constexpr int NPHASE = 12;

struct Params { const float* in[14]; float* out; unsigned char* ws; int ph_lo, ph_hi; };

__device__ __forceinline__ float bf2f(unsigned h) { return __uint_as_float(h << 16); }
__device__ __forceinline__ float bflo(unsigned w) { return __uint_as_float(w << 16); }
__device__ __forceinline__ float bfhi(unsigned w) { return __uint_as_float(w & 0xffff0000u); }
typedef __bf16 bf16v2_t __attribute__((ext_vector_type(2)));
__device__ __forceinline__ unsigned pk2(float a, float b) { const f32x2 v = {a, b}; const bf16v2_t r = __builtin_convertvector(v, bf16v2_t); return __builtin_bit_cast(unsigned, r); }
__device__ __forceinline__ float sigm(float x) { return __builtin_amdgcn_rcpf(1.f + __expf(-x)); }
__device__ __forceinline__ float siluf(float x) { return x * __builtin_amdgcn_rcpf(1.f + __expf(-x)); }
__device__ __forceinline__ float wave_sum(float v) {
#pragma unroll
    for (int o = 1; o < 64; o <<= 1) v += __shfl_xor(v, o);
    return v;
}
__device__ __forceinline__ float rdlane_f(float v, int l) { return __int_as_float(__builtin_amdgcn_readlane(__float_as_int(v), l)); }
__device__ __forceinline__ void st_b64_untracked(void* ptr, u32x2 v) { asm volatile("global_store_dwordx2 %0, %1, off" :: "v"(ptr), "v"(v) : "memory"); }
__device__ __forceinline__ void touch4(unsigned a, unsigned b, unsigned c, unsigned d) { asm volatile("" :: "v"(a), "v"(b), "v"(c), "v"(d)); }
#define LDS_WAIT() asm volatile("s_waitcnt lgkmcnt(0)" ::: "memory")

__device__ __forceinline__ int orig_col(int c) {
    return c < 2048 ? c : (c < 3584 ? c + 512 : (c < 3600 ? c + 1024 : (c < 3840 ? -1 : (c < 6400 ? c + 1296 : (c < 6912 ? c - 4352 : (c < 7424 ? c - 2816 : c - 2800))))));
}
template <bool REMAP>
__device__ __forceinline__ void p0_transpose_item(const float* W, int K, int N, bf16_t* WT, LAS float* scr, int item, int nblk, int lane) {
    const int kb = item / nblk, nb = item % nblk, k0 = 64 * kb, n0 = 32 * nb;
    const int cc = n0 + (lane & 31); const int oc = REMAP ? orig_col(cc) : cc;
    float wv_[32];
#pragma unroll
    for (int i = 0; i < 32; ++i) { const int kk = 2 * i + (lane >> 5); wv_[i] = (oc >= 0) ? W[(size_t)(k0 + kk) * N + oc] : 0.f; }
#pragma unroll
    for (int i = 0; i < 32; ++i) { const int kk = 2 * i + (lane >> 5); scr[kk * 33 + (lane & 31)] = wv_[i]; }
    LDS_WAIT(); asm volatile("" ::: "memory");
    const int c = lane & 7;
#pragma unroll
    for (int j = 0; j < 4; ++j) { const int n = (lane >> 3) + 8 * j; const LAS float* s = scr + (8 * c) * 33 + n;
        u32x4 o; o.x = pk2(s[0 * 33], s[1 * 33]); o.y = pk2(s[2 * 33], s[3 * 33]); o.z = pk2(s[4 * 33], s[5 * 33]); o.w = pk2(s[6 * 33], s[7 * 33]);
        *(u32x4*)(WT + (size_t)(n0 + n) * K + k0 + 8 * c) = o; }
    LDS_WAIT(); asm volatile("" ::: "memory");
}
__device__ __forceinline__ void weight_transposes(const Params& p, LAS unsigned char* lds, int l, int gw, int NGW) {
    const int lane = opaque_tid() & 63, wave = (opaque_tid() >> 6) & 7;
    LAS float* scr = (LAS float*)(lds + wave * 16384);
    bf16_t* WinT = (bf16_t*)(p.ws + WS_WIN); bf16_t* WoutT = (bf16_t*)(p.ws + WS_WOUT);
    constexpr int I_IN = (D / 64) * (NP / 32), I_OUT = (D / 64) * (D / 32), NITEMS = I_IN + I_OUT;
    for (int it = gw; it < NITEMS; it += NGW) {
        if (it < I_IN) p0_transpose_item<true>(p.in[8] + (size_t)l * D * NPW, D, NPW, WinT + (size_t)l * NP * D, scr, it, NP / 32, lane);
        else p0_transpose_item<false>(p.in[13] + (size_t)l * D * D, D, D, WoutT + (size_t)l * D * D, scr, it - I_IN, D / 32, lane);
    }
}
__device__ __forceinline__ void p0_prologue(const Params& p, LAS unsigned char* lds) {
    const int tid = opaque_tid(), lane = tid & 63, wave = tid >> 6;
    LAS float* scr = (LAS float*)(lds + wave * 16384);
    const int gw = blockIdx.x * 8 + wave, NGW = gridDim.x * 8;
    bf16_t* WinT = (bf16_t*)(p.ws + WS_WIN); bf16_t* WoutT = (bf16_t*)(p.ws + WS_WOUT);
    float* mod = (float*)(p.ws + WS_MOD);
    if (blockIdx.x == 0) {
        float* tab = (float*)(p.ws + WS_ROPE);
        for (int idx = tid; idx < 64 * 32; idx += 512) { const int pos = idx >> 5, i = idx & 31;
            const float inv = __builtin_amdgcn_exp2f(-(float)i * (13.287712379549449f / 32.f)); const float ang = (float)pos * inv;
            tab[2 * idx] = __cosf(ang); tab[2 * idx + 1] = __sinf(ang); }
    }
    constexpr int MOD_TASKS = 2 * 96 * 16;
    for (int task = gw; task < MOD_TASKS; task += NGW) {
        const int l = task / 1536, r = task % 1536, cgp = r % 96, kr = r / 96, n = cgp * 64 + lane, k0 = kr * 128;
        for (int idx = lane; idx < 640; idx += 64) { const int v = idx >> 7, kk = idx & 127; const float s = (v < 4) ? p.in[1][v * D + k0 + kk] : p.in[3][k0 + kk]; scr[idx] = siluf(s); }
        LDS_WAIT(); asm volatile("" ::: "memory");
        float acc[5] = {0.f, 0.f, 0.f, 0.f, 0.f};
        const float* wp = p.in[4] + (size_t)l * D * NMOD + (size_t)k0 * NMOD + n;
#pragma unroll 8
        for (int kk = 0; kk < 128; ++kk) { const float w = wp[(size_t)kk * NMOD];
#pragma unroll
            for (int v = 0; v < 5; ++v) acc[v] += scr[v * 128 + kk] * w; }
        if (kr == 0) { const float bb = p.in[5][l * NMOD + n];
#pragma unroll
            for (int v = 0; v < 5; ++v) acc[v] += bb; }
#pragma unroll
        for (int v = 0; v < 5; ++v) atomicAdd(mod + ((size_t)l * 5 + v) * NMOD + n, acc[v]);
        LDS_WAIT(); asm volatile("" ::: "memory");
    }
    const bool defer1 = (int)gridDim.x > 2 * SCAN_WGS;
    weight_transposes(p, lds, 0, gw, NGW);
    if (!defer1) weight_transposes(p, lds, 1, gw, NGW);
}

__device__ __forceinline__ void post_stage(f32x4 (&v)[8], const f32x4 (&y)[8], float rs, const float* __restrict__ gp, const float* __restrict__ gate, float* __restrict__ dst, int lane, bool nt) {
#pragma unroll
    for (int h2 = 0; h2 < 2; ++h2) {
        f32x4 g[4], ga[4];
#pragma unroll
        for (int j = 0; j < 4; ++j) { g[j] = *((const f32x4*)gp + lane + 64 * (4 * h2 + j)); ga[j] = *((const f32x4*)gate + lane + 64 * (4 * h2 + j)); }
#pragma unroll
        for (int j = 0; j < 4; ++j) { const int jj = 4 * h2 + j; v[jj] = v[jj] + ga[j] * (y[jj] * rs * g[j]); if (nt) __builtin_nontemporal_store(v[jj], (f32x4*)dst + lane + 64 * jj); else *((f32x4*)dst + lane + 64 * jj) = v[jj]; }
    }
}
__device__ __forceinline__ void pre_stage(const f32x4 (&v)[8], float rs, const float* __restrict__ gp, const float* __restrict__ sc, const float* __restrict__ sh, u32x2* __restrict__ ar, int lane) {
#pragma unroll
    for (int h2 = 0; h2 < 2; ++h2) {
        f32x4 g[4], s1[4], s0[4];
#pragma unroll
        for (int j = 0; j < 4; ++j) { g[j] = *((const f32x4*)gp + lane + 64 * (4 * h2 + j)); s1[j] = *((const f32x4*)sc + lane + 64 * (4 * h2 + j)); s0[j] = *((const f32x4*)sh + lane + 64 * (4 * h2 + j)); }
#pragma unroll
        for (int j = 0; j < 4; ++j) { const f32x4 o = (v[4 * h2 + j] * rs * g[j]) * (s1[j] + 1.f) + s0[j]; u32x2 w; w.x = pk2(o.x, o.y); w.y = pk2(o.z, o.w); ar[lane + 64 * (4 * h2 + j)] = w; }
    }
}
template <int MODE, int NR>
__device__ __forceinline__ void row_body(const Params& p, int m0, int mstride, int lane) {
    const float* mod = (const float*)(p.ws + WS_MOD);
    const bf16_t* Yout = (const bf16_t*)(p.ws + WS_P);
    float* hctx = (float*)(p.ws + WS_HCTX);
    bf16_t* A = (bf16_t*)(p.ws + WS_A);
    f32x4 v[NR][8]; f32x4 y[NR][8]; int mv[NR]; float* dst[NR]; int mrow[NR];
#pragma unroll
    for (int q = 0; q < NR; ++q) {
        const int m = m0 + q * mstride; mrow[q] = m;
        const int b = m / TT, tok = m - b * TT; const bool isctx = tok < CTXL;
        mv[q] = isctx ? 4 : b;
        const float* src;
        if (MODE <= 1) src = isctx ? p.in[2] + ((size_t)b * CTXL + tok) * D : p.in[0] + ((size_t)b * SEQ + (tok - CTXL)) * D;
        else src = p.out + ((size_t)b * SEQ + (tok - CTXL)) * D;
        if (MODE == 0) dst[q] = nullptr;
        else if (MODE == 1) dst[q] = isctx ? hctx + ((size_t)b * CTXL + tok) * D : p.out + ((size_t)b * SEQ + (tok - CTXL)) * D;
        else dst[q] = p.out + ((size_t)b * SEQ + (tok - CTXL)) * D;
#pragma unroll
        for (int j = 0; j < 8; ++j) v[q][j] = __builtin_nontemporal_load((const f32x4*)src + lane + 64 * j);
        if (MODE >= 1) { const bf16_t* yr = Yout + (size_t)m * D;
#pragma unroll
            for (int j = 0; j < 8; ++j) { const u32x2 yw = __builtin_nontemporal_load((const u32x2*)yr + lane + 64 * j); y[q][j] = (f32x4){bflo(yw.x), bfhi(yw.x), bflo(yw.y), bfhi(yw.y)}; } }
    }
    if (MODE >= 1) {
        const int lpost = MODE - 1; const float* gp = p.in[7] + lpost * D;
#pragma unroll
        for (int q = 0; q < NR; ++q) {
            const float* gate = mod + ((size_t)lpost * 5 + mv[q]) * NMOD + 2 * D; float ss = 0.f;
#pragma unroll
            for (int j = 0; j < 8; ++j) ss += (y[q][j].x * y[q][j].x + y[q][j].y * y[q][j].y) + (y[q][j].z * y[q][j].z + y[q][j].w * y[q][j].w);
            const float rs = __builtin_amdgcn_rsqf(wave_sum(ss) * (1.f / D) + EPS);
            post_stage(v[q], y[q], rs, gp, gate, dst[q], lane, MODE == 2);
        }
    }
    if (MODE <= 1) {
        const int lpre = MODE; const float* gp = p.in[6] + lpre * D;
#pragma unroll
        for (int q = 0; q < NR; ++q) {
            const float* sh = mod + ((size_t)lpre * 5 + mv[q]) * NMOD; const float* sc = sh + D; float ss = 0.f;
#pragma unroll
            for (int j = 0; j < 8; ++j) ss += (v[q][j].x * v[q][j].x + v[q][j].y * v[q][j].y) + (v[q][j].z * v[q][j].z + v[q][j].w * v[q][j].w);
            const float rs = __builtin_amdgcn_rsqf(wave_sum(ss) * (1.f / D) + EPS);
            pre_stage(v[q], rs, gp, sc, sh, (u32x2*)(A + (size_t)mrow[q] * D), lane);
        }
    }
}
template <int MODE>
__device__ __forceinline__ void row_phase(const Params& p) {
    const int tid = opaque_tid(), lane = tid & 63, wave = tid >> 6;
    const int gw = blockIdx.x * 8 + wave, NGW = gridDim.x * 8;
    if (MODE == 2) {
        int r = gw;
        for (; r + NGW < NBATCH * SEQ; r += 2 * NGW) { const int ma = (r / SEQ) * TT + CTXL + (r % SEQ), r2 = r + NGW, mb = (r2 / SEQ) * TT + CTXL + (r2 % SEQ); row_body<MODE, 2>(p, ma, mb - ma, lane); }
        if (r < NBATCH * SEQ) row_body<MODE, 1>(p, (r / SEQ) * TT + CTXL + (r % SEQ), 0, lane);
    } else if (MODE == 0) {
        int m = gw;
        for (; m + 3 * NGW < MROWS; m += 4 * NGW) row_body<MODE, 4>(p, m, NGW, lane);
        for (; m < MROWS; m += NGW) row_body<MODE, 1>(p, m, 0, lane);
    } else {
        int m = gw;
        for (; m + NGW < MROWS; m += 2 * NGW) row_body<MODE, 2>(p, m, NGW, lane);
        if (m < MROWS) row_body<MODE, 1>(p, m, 0, lane);
    }
}

constexpr int TC = 16, NCH = TT / TC;
constexpr int SC_A = 0, SC_B = SC_A + TC * 128 * 4, SC_Q = SC_B + TC * 128 * 4, SC_V = SC_Q + TC * 128 * 4, SC_O = SC_V + TC * 36 * 4, SC_N = SC_O + TC * 8 * 32 * 4, SC_END = SC_N + TC * 64 * 4;
template <int CTRL> __device__ __forceinline__ float dpp_quad(float v) { return __int_as_float(__builtin_amdgcn_mov_dpp(__float_as_int(v), CTRL, 0xf, 0xf, true)); }

template <int BR>
__device__ __forceinline__ void scan_unit(const Params& p, int layer, int unit, LAS unsigned char* lds) {
    const int tid = opaque_tid(), lane = tid & 63, wave = tid >> 6;
    const int dir = (unit >> 6) & 1, b = (unit >> 4) & 3, h = (unit >> 2) & 3, colq = unit & 3;
    const bf16_t* P = (const bf16_t*)(p.ws + WS_P);
    bf16_t* Ob = (bf16_t*)(p.ws + WS_O) + (size_t)dir * MROWS * 1024 + BR * 512 + h * 128 + colq * 32;
    LAS float* SA = (LAS float*)(lds + SC_A); LAS float* SB = (LAS float*)(lds + SC_B); LAS float* SQ = (LAS float*)(lds + SC_Q);
    LAS float* SV = (LAS float*)(lds + SC_V); LAS float* OB = (LAS float*)(lds + SC_O); LAS float* NBF = (LAS float*)(lds + SC_N);
    const int ts = tid >> 5, lj = tid & 31;
    float lb[4] = {0.f, 0.f, 0.f, 0.f};
    float cwq[3][4], cwk[3][4]; float bias_i = 0.f, bias_f = 0.f;
    if (BR == 0) {
        if (layer == 1) {
#pragma unroll
            for (int e = 0; e < 4; ++e) { const int idx = dir * 512 + h * 128 + 4 * lj + e; lb[e] = sigm(p.in[9][1024 + idx] - p.in[9][idx]); }
        }
    } else {
        const float* cw = p.in[10] + (size_t)layer * 3 * 1024;
#pragma unroll
        for (int tp = 0; tp < 3; ++tp)
#pragma unroll
            for (int e = 0; e < 4; ++e) { cwq[tp][e] = cw[tp * 1024 + h * 128 + 4 * lj + e]; cwk[tp][e] = cw[tp * 1024 + 512 + h * 128 + 4 * lj + e]; }
        bias_i = p.in[11][layer * 16 + (2 * dir) * 4 + h]; bias_f = p.in[11][layer * 16 + (2 * dir + 1) * 4 + h];
    }
    u32x2 rq[3], rk[3]; unsigned rv = 0, rgi = 0, rgf = 0; int mrow = 0; float okf[3] = {1.f, 1.f, 1.f};
    auto issue = [&](int ch) {
        const int t = ch * TC + ts; const int tok = dir ? (t < CTXL ? (CTXL - 1 - t) : (TT + CTXL - 1 - t)) : t;
        mrow = b * TT + tok;
        const bf16_t* pr = P + (size_t)mrow * NP;
        if (BR == 0) {
            rq[0] = *(const u32x2*)(pr + C_AQ + h * 128 + 4 * lj);
            rk[0] = *(const u32x2*)(pr + (dir ? C_AFB : C_AFF) + h * 128 + 4 * lj);
            rv = pr[C_AI + h * 128 + colq * 32 + lj];
        } else {
            const int lo = tok < CTXL ? 0 : CTXL, hi = tok < CTXL ? CTXL - 1 : TT - 1;
#pragma unroll
            for (int tp = 0; tp < 3; ++tp) { const int tn = tok + tp - 1; const bool ok = (tn >= lo) && (tn <= hi); const bf16_t* pn = P + (size_t)(b * TT + (ok ? tn : tok)) * NP;
                rq[tp] = *(const u32x2*)(pn + C_BQ + h * 128 + 4 * lj); rk[tp] = *(const u32x2*)(pn + C_BK + h * 128 + 4 * lj); okf[tp] = ok ? 1.f : 0.f; }
            rv = pr[C_BV + h * 128 + colq * 32 + lj];
            rgi = pr[C_GT + (2 * dir) * 4 + h]; rgf = pr[C_GT + (2 * dir + 1) * 4 + h];
        }
    };
    auto convert = [&]() {
        f32x4 av, bv, qv; float vv;
        if (BR == 0) {
            const float zq[4] = {bflo(rq[0].x), bfhi(rq[0].x), bflo(rq[0].y), bfhi(rq[0].y)};
            const float zf[4] = {bflo(rk[0].x), bfhi(rk[0].x), bflo(rk[0].y), bfhi(rk[0].y)};
#pragma unroll
            for (int e = 0; e < 4; ++e) { const float kk = (1.f - lb[e]) * sigm(-zf[e]); bv[e] = kk; av[e] = 1.f - kk; qv[e] = siluf(zq[e]); }
            vv = bf2f(rv);
        } else {
            const float fg = sigm(bf2f(rgf) + bias_f), ig = __expf(bf2f(rgi) + bias_i);
            float cq[4] = {0.f, 0.f, 0.f, 0.f}, ck[4] = {0.f, 0.f, 0.f, 0.f};
#pragma unroll
            for (int tp = 0; tp < 3; ++tp) {
                const float xq[4] = {bflo(rq[tp].x), bfhi(rq[tp].x), bflo(rq[tp].y), bfhi(rq[tp].y)};
                const float xk[4] = {bflo(rk[tp].x), bfhi(rk[tp].x), bflo(rk[tp].y), bfhi(rk[tp].y)};
#pragma unroll
                for (int e = 0; e < 4; ++e) { cq[e] += (cwq[tp][e] * okf[tp]) * xq[e]; ck[e] += (cwk[tp][e] * okf[tp]) * xk[e]; }
            }
#pragma unroll
            for (int e = 0; e < 4; ++e) { av[e] = fg; bv[e] = siluf(ck[e]); qv[e] = siluf(cq[e]) * 0.08838834764831845f; }
            vv = bf2f(rv) * ig;
            if (lj == 0) SV[ts * 36 + 32] = ig;
        }
        *(LAS f32x4*)(SA + ts * 128 + 4 * lj) = av; *(LAS f32x4*)(SB + ts * 128 + 4 * lj) = bv; *(LAS f32x4*)(SQ + ts * 128 + 4 * lj) = qv;
        SV[ts * 36 + lj] = vv;
    };
    const int cp = lane >> 2, dq = lane & 3, d0 = wave * 16 + dq * 4;
    f32x2 S[2][2]; S[0][0] = S[0][1] = S[1][0] = S[1][1] = (f32x2){0.f, 0.f};
    issue(0); convert();
    __syncthreads();
    f32x2 nn = {0.f, 0.f};
    for (int ch = 0; ch < NCH; ++ch) {
        const int mrow_cur = mrow;
        if (ch + 1 < NCH) issue(ch + 1);
        f32x4 ga[2][4], gb[2][4], gq[2][4]; f32x2 gv[2][4];
#define SC_LOADG(bufi, g) do { _Pragma("unroll") for (int k = 0; k < 4; ++k) { const int s_ = 4 * (g) + k; \
            ga[bufi][k] = *(const LAS f32x4*)(SA + s_ * 128 + d0); gb[bufi][k] = *(const LAS f32x4*)(SB + s_ * 128 + d0); gq[bufi][k] = *(const LAS f32x4*)(SQ + s_ * 128 + d0); \
            gv[bufi][k] = *(const LAS f32x2*)(SV + s_ * 36 + 2 * cp); } } while (0)
        SC_LOADG(0, 0);
#pragma unroll
        for (int g = 0; g < 4; ++g) {
            const int cb = g & 1;
            if (g < 3) SC_LOADG(cb ^ 1, g + 1);
            float ov[4];
#pragma unroll
            for (int k = 0; k < 4; ++k) {
                const f32x4 a = ga[cb][k], bb = gb[cb][k], q = gq[cb][k]; const f32x2 v = gv[cb][k];
                const f32x2 a0 = {a.x, a.y}, a1 = {a.z, a.w}, b0 = {bb.x, bb.y}, b1 = {bb.z, bb.w}, q0 = {q.x, q.y}, q1 = {q.z, q.w};
                float o[2];
#pragma unroll
                for (int c = 0; c < 2; ++c) {
                    const f32x2 vc = {v[c], v[c]};
                    S[c][0] = a0 * S[c][0] + b0 * vc; S[c][1] = a1 * S[c][1] + b1 * vc;
                    const f32x2 t2 = S[c][0] * q0 + S[c][1] * q1; o[c] = t2.x + t2.y;
                }
                o[0] += dpp_quad<0xB1>(o[0]); o[1] += dpp_quad<0xB1>(o[1]);
                o[0] += dpp_quad<0x4E>(o[0]); o[1] += dpp_quad<0x4E>(o[1]);
                ov[k] = (dq & 1) ? o[1] : o[0];
            }
#pragma unroll
            for (int k = 0; k < 4; ++k) OB[((4 * g + k) * 8 + wave) * 32 + 2 * cp + (dq & 1)] = ov[k];
        }
        if (BR == 1 && wave == 7) {
#pragma unroll
            for (int s = 0; s < TC; ++s) {
                const f32x2 b2 = *(const LAS f32x2*)(SB + s * 128 + 2 * lane), q2 = *(const LAS f32x2*)(SQ + s * 128 + 2 * lane);
                const float fg = SA[s * 128], ig = SV[s * 36 + 32];
                nn = nn * fg + b2 * ig;
                NBF[s * 64 + lane] = nn.x * q2.x + nn.y * q2.y;
            }
        }
        __syncthreads();
        if (ch + 1 < NCH) convert();
        {
            float num = 0.f;
#pragma unroll
            for (int w = 0; w < 8; ++w) num += OB[(ts * 8 + w) * 32 + lj];
            if (BR == 1) { float den = NBF[ts * 64 + lj] + NBF[ts * 64 + 32 + lj];
                den += __shfl_xor(den, 1); den += __shfl_xor(den, 2); den += __shfl_xor(den, 4); den += __shfl_xor(den, 8); den += __shfl_xor(den, 16);
                num = num / fmaxf(fabsf(den), 1.f); }
            Ob[(size_t)mrow_cur * 1024 + lj] = (bf16_t)(pk2(num, 0.f) & 0xffffu);
        }
        __syncthreads();
    }
#undef SC_LOADG
}

#define MFMA32(a, b, c) __builtin_amdgcn_mfma_f32_32x32x16_bf16((a), (b), (c), 0, 0, 0)
constexpr int ML = 32, MNCH = TT / ML;
constexpr int MS_ROW = 272, MS_TROW = 80;
constexpr int MS_QT = 0, MS_BT = MS_QT + 32 * MS_ROW, MS_BTT = MS_BT + 32 * MS_ROW, MS_VT = MS_BTT + 128 * MS_TROW, MS_AL = MS_VT + 128 * MS_TROW,
              MS_IV = MS_AL + 512, MS_NV = MS_IV + 128, MS_XA = MS_NV + 1024, MS_XO = MS_XA + 5120, MS_GRP = MS_XO + 16384;
__device__ __forceinline__ bf16x8 pack8(const f32x16& x, int s) {
    u32x4 w; w.x = pk2(x[8 * s], x[8 * s + 1]); w.y = pk2(x[8 * s + 2], x[8 * s + 3]); w.z = pk2(x[8 * s + 4], x[8 * s + 5]); w.w = pk2(x[8 * s + 6], x[8 * s + 7]);
    return __builtin_bit_cast(bf16x8, w);
}
__device__ __forceinline__ bf16x8 ld2x64(const LAS unsigned char* p0) {
    const u32x2 lo = *(const LAS u32x2*)(p0), hi = *(const LAS u32x2*)(p0 + 16);
    u32x4 w; w.x = lo.x; w.y = lo.y; w.z = hi.x; w.w = hi.y; return __builtin_bit_cast(bf16x8, w);
}
template <int BR>
__device__ __forceinline__ void scan_mfma(const Params& p, int layer, int seq, LAS unsigned char* lds) {
    const int tid = opaque_tid(), lane = tid & 63, wave = __builtin_amdgcn_readfirstlane(tid >> 6), wv = wave & 3, dh = wave >> 2, r = lane & 31, hh = lane >> 5;
    const int dir = (seq >> 4) & 1, b = (seq >> 2) & 3, h = seq & 3;
    LAS float* AL = (LAS float*)(lds + MS_AL); LAS float* IV = (LAS float*)(lds + MS_IV); LAS float* NV = (LAS float*)(lds + MS_NV); LAS float* XA = (LAS float*)(lds + MS_XA);
    LAS float* XO = (LAS float*)(lds + MS_XO);
    const bf16_t* P = (const bf16_t*)(p.ws + WS_P);
    bf16_t* Ob = (bf16_t*)(p.ws + WS_O) + (size_t)dir * MROWS * 1024 + BR * 512 + h * 128;
    const int colA = h * 128 + 2 * lane;
    const int cF = dir ? C_AFB : C_AFF;
    float lb[2] = {0.f, 0.f}; float cwq[3][2], cwk[3][2]; float bias_g = 0.f;
    if (BR == 0) { if (layer == 1) {
#pragma unroll
            for (int e = 0; e < 2; ++e) { const int idx = dir * 512 + colA + e; lb[e] = sigm(p.in[9][1024 + idx] - p.in[9][idx]); } }
    } else {
        const float* cw = p.in[10] + (size_t)layer * 3 * 1024;
#pragma unroll
        for (int tp = 0; tp < 3; ++tp)
#pragma unroll
            for (int e = 0; e < 2; ++e) { cwq[tp][e] = cw[tp * 1024 + colA + e]; cwk[tp][e] = cw[tp * 1024 + 512 + colA + e]; }
        bias_g = p.in[11][layer * 16 + 8 * dir + 4 * (lane & 1) + h];
    }
    unsigned rq[2][6], rk[2][6], rv[2][4], rg[2] = {0u, 0u}; float oklo[2] = {1.f, 1.f}, okhi[2] = {1.f, 1.f};
    auto tok_of = [&](int t) { return dir ? (t < CTXL ? (CTXL - 1 - t) : (TT + CTXL - 1 - t)) : t; };
    const char* Pb = (const char*)P;
#define LDU32(byteoff) (*(const unsigned*)(Pb + (unsigned)(byteoff)))
    auto issue = [&](int ch, auto SETC) {
        constexpr int st = decltype(SETC)::value;
        const int t0 = (ch < MNCH ? ch : MNCH - 1) * ML + 4 * wave;
        constexpr unsigned RB = 2u * NP;
        if (BR == 0) {
            const unsigned o0 = ((unsigned)(b * TT + tok_of(t0)) * (unsigned)NP + (unsigned)colA) * 2u;
#pragma unroll
            for (int k = 0; k < 4; ++k) { const unsigned o = dir ? o0 - (unsigned)k * RB : o0 + (unsigned)k * RB;
                rq[st][k] = LDU32(o + 2u * C_AQ); rk[st][k] = LDU32(o + 2u * (unsigned)cF); rv[st][k] = LDU32(o + 2u * C_AI); }
        } else {
            const int tk0 = dir ? tok_of(t0 + 3) : tok_of(t0);
            const int lo = tk0 < CTXL ? 0 : CTXL, hi = tk0 < CTXL ? CTXL - 1 : TT - 1;
            oklo[st] = (tk0 > lo) ? 1.f : 0.f; okhi[st] = (tk0 + 3 < hi) ? 1.f : 0.f;
            const unsigned o0 = ((unsigned)(b * TT + tk0) * (unsigned)NP + (unsigned)colA) * 2u;
#pragma unroll
            for (int w = 0; w < 6; ++w) { const unsigned o = (w == 0) ? (tk0 > lo ? o0 - RB : o0) : ((w == 5) ? (tk0 + 3 < hi ? o0 + 4u * RB : o0 + 3u * RB) : o0 + (unsigned)(w - 1) * RB);
                rq[st][w] = LDU32(o + 2u * C_BQ); rk[st][w] = LDU32(o + 2u * C_BK); }
#pragma unroll
            for (int k = 0; k < 4; ++k) { const unsigned o = o0 + (unsigned)(dir ? 3 - k : k) * RB; rv[st][k] = LDU32(o + 2u * C_BV); }
            { const int k = (lane >> 1) & 3; const unsigned o = ((unsigned)(b * TT + tk0 + (dir ? 3 - k : k)) * (unsigned)NP + (unsigned)(C_GT + 8 * dir + 4 * (lane & 1) + h)) * 2u; rg[st] = *(const unsigned short*)(Pb + o); }
        }
    };
#undef LDU32
    float gvec = 0.f; float hb[4][2] = {{0.f, 0.f}, {0.f, 0.f}, {0.f, 0.f}, {0.f, 0.f}};
    auto part1 = [&](auto SETC) {
        constexpr int st = decltype(SETC)::value;
        float run0 = 1.f, run1 = 1.f;
        if (BR == 0) {
#pragma unroll
            for (int k = 0; k < 4; ++k) { hb[k][0] = (1.f - lb[0]) * sigm(-bflo(rk[st][k])); hb[k][1] = (1.f - lb[1]) * sigm(-bfhi(rk[st][k])); run0 *= (1.f - hb[k][0]); run1 *= (1.f - hb[k][1]); }
        } else {
            gvec = (lane & 1) ? sigm(bf2f(rg[st]) + bias_g) : __expf(bf2f(rg[st]) + bias_g);
#pragma unroll
            for (int k = 0; k < 4; ++k) run0 *= rdlane_f(gvec, 2 * k + 1);
            run1 = run0;
        }
        if (BR == 0) *(LAS f32x2*)(XA + wave * 128 + 2 * lane) = (f32x2){run0, run1};
        else if (lane == 0) XA[9 * 128 + wave] = run0;
        touch4(rq[st][0], rq[st][1], rq[st][2], rq[st][3]); touch4(rv[st][0], rv[st][1], rv[st][2], rv[st][3]);
        if (BR == 1) { touch4(rq[st][4], rq[st][5], rk[st][0], rk[st][1]); touch4(rk[st][2], rk[st][3], rk[st][4], rk[st][5]); }
    };
    auto part2 = [&](auto SETC) {
        constexpr int st = decltype(SETC)::value;
        float run0 = 1.f, run1 = 1.f;
        if (BR == 0) {
#pragma unroll
            for (int q0 = 0; q0 < 8; q0 += 4) {
                f32x2 xs[4];
#pragma unroll
                for (int qd = 0; qd < 4; ++qd) xs[qd] = *(const LAS f32x2*)(XA + ((q0 + qd) < wave ? (q0 + qd) : 8) * 128 + 2 * lane);
#pragma unroll
                for (int qd = 0; qd < 4; ++qd) { run0 *= xs[qd].x; run1 *= xs[qd].y; }
            }
        } else {
            const f32x4 x0 = *(const LAS f32x4*)(XA + 9 * 128), x1 = *(const LAS f32x4*)(XA + 9 * 128 + 4);
            const float xv[8] = {x0.x, x0.y, x0.z, x0.w, x1.x, x1.y, x1.z, x1.w};
#pragma unroll
            for (int qd = 0; qd < 7; ++qd) run0 *= (qd < wave) ? xv[qd] : 1.f;
            run1 = run0;
        }
        unsigned bt0[2], bt1[2], vt0[2], vt1[2]; float bprev0 = 0.f, bprev1 = 0.f, vprev0 = 0.f, vprev1 = 0.f;
        if (BR == 1) { if (oklo[st] == 0.f) { rq[st][0] = 0u; rk[st][0] = 0u; } if (okhi[st] == 0.f) { rq[st][5] = 0u; rk[st][5] = 0u; } }
#pragma unroll
        for (int k = 0; k < 4; ++k) {
            float q0, q1, b0, b1, v0, v1;
            if (BR == 0) {
                b0 = hb[k][0]; b1 = hb[k][1];
                run0 *= (1.f - b0); run1 *= (1.f - b1);
                q0 = siluf(bflo(rq[st][k])); q1 = siluf(bfhi(rq[st][k])); v0 = bflo(rv[st][k]); v1 = bfhi(rv[st][k]);
            } else {
                const float ig = rdlane_f(gvec, 2 * k), fg = rdlane_f(gvec, 2 * k + 1);
                const int wc = 1 + (dir ? 3 - k : k);
                float cq0 = 0.f, cq1 = 0.f, ck0 = 0.f, ck1 = 0.f;
#pragma unroll
                for (int tp = 0; tp < 3; ++tp) { const int w = wc + tp - 1;
                    cq0 += cwq[tp][0] * bflo(rq[st][w]); cq1 += cwq[tp][1] * bfhi(rq[st][w]); ck0 += cwk[tp][0] * bflo(rk[st][w]); ck1 += cwk[tp][1] * bfhi(rk[st][w]); }
                run0 *= fg; run1 = run0;
                b0 = siluf(ck0); b1 = siluf(ck1); q0 = siluf(cq0) * 0.08838834764831845f; q1 = siluf(cq1) * 0.08838834764831845f;
                v0 = bflo(rv[st][k]) * ig; v1 = bfhi(rv[st][k]) * ig;
            }
            const float A0 = fmaxf(run0, 1e-30f), A1 = fmaxf(run1, 1e-30f);
            const float bh0 = b0 * __builtin_amdgcn_rcpf(A0), bh1 = b1 * __builtin_amdgcn_rcpf(A1);
            *(LAS unsigned*)(lds + MS_QT + (4 * wave + k) * MS_ROW + 4 * lane) = pk2(q0 * A0, q1 * A1);
            *(LAS unsigned*)(lds + MS_BT + (4 * wave + k) * MS_ROW + 4 * lane) = pk2(bh0, bh1);
            if (k & 1) { bt0[k >> 1] = pk2(bprev0, bh0); bt1[k >> 1] = pk2(bprev1, bh1); vt0[k >> 1] = pk2(vprev0, v0); vt1[k >> 1] = pk2(vprev1, v1); }
            else { bprev0 = bh0; bprev1 = bh1; vprev0 = v0; vprev1 = v1; }
        }
        *(LAS u32x2*)(lds + MS_BTT + (2 * lane) * MS_TROW + 8 * wave) = (u32x2){bt0[0], bt0[1]};
        *(LAS u32x2*)(lds + MS_BTT + (2 * lane + 1) * MS_TROW + 8 * wave) = (u32x2){bt1[0], bt1[1]};
        *(LAS u32x2*)(lds + MS_VT + (2 * lane) * MS_TROW + 8 * wave) = (u32x2){vt0[0], vt0[1]};
        *(LAS u32x2*)(lds + MS_VT + (2 * lane + 1) * MS_TROW + 8 * wave) = (u32x2){vt1[0], vt1[1]};
        if (wave == 7) *(LAS f32x2*)(AL + 2 * lane) = (f32x2){fmaxf(run0, 1e-30f), fmaxf(run1, 1e-30f)};
        if (BR == 1 && lane < 8 && !(lane & 1)) IV[4 * wave + (lane >> 1)] = gvec;
    };
    const std::integral_constant<int, 0> IC0{}; const std::integral_constant<int, 1> IC1{};
    f32x16 S[2];
#pragma unroll
    for (int k = 0; k < 2; ++k)
#pragma unroll
        for (int i = 0; i < 16; ++i) S[k][i] = 0.f;
    if (BR == 1 && tid < 128) { NV[tid] = 0.f; }
    if (tid < 128) XA[8 * 128 + tid] = 1.f;
    __syncthreads();
    issue(0, IC0); issue(1, IC1); part1(IC0);
    __syncthreads();
    part2(IC0);
    __builtin_amdgcn_sched_barrier(0);
    issue(2, IC0);
    __syncthreads();
    auto iter = [&](int ch, auto SETN) {
        const int nvc = (ch & 1) * 128, nvn = 128 - nvc;
        if (dh == 0) __builtin_amdgcn_s_setprio(2);
        f32x16 ot, ot2; float den = 0.f;
#pragma unroll
        for (int i = 0; i < 16; ++i) { ot[i] = 0.f; ot2[i] = 0.f; }
#pragma unroll
        for (int ks = 0; ks < 2; ++ks) {
            const bf16x8 qa = ld2x64(lds + MS_QT + r * MS_ROW + (32 * (2 * dh) + 16 * ks + 4 * hh) * 2), qb = ld2x64(lds + MS_QT + r * MS_ROW + (32 * (2 * dh + 1) + 16 * ks + 4 * hh) * 2);
            ot = MFMA32(pack8(S[0], ks), qa, ot); ot2 = MFMA32(pack8(S[1], ks), qb, ot2);
        }
        if (dh == 0) {
            f32x16 pt, pt2;
#pragma unroll
            for (int i = 0; i < 16; ++i) { pt[i] = 0.f; pt2[i] = 0.f; }
#pragma unroll
            for (int k = 0; k < 4; ++k) {
                const bf16x8 af = *(const LAS bf16x8*)(lds + MS_BT + r * MS_ROW + (16 * k + 8 * hh) * 2), bfr = *(const LAS bf16x8*)(lds + MS_QT + r * MS_ROW + (16 * k + 8 * hh) * 2);
                const bf16x8 af2 = *(const LAS bf16x8*)(lds + MS_BT + r * MS_ROW + (16 * (k + 4) + 8 * hh) * 2), bfr2 = *(const LAS bf16x8*)(lds + MS_QT + r * MS_ROW + (16 * (k + 4) + 8 * hh) * 2);
                pt = MFMA32(af, bfr, pt); pt2 = MFMA32(af2, bfr2, pt2); }
#pragma unroll
            for (int i = 0; i < 16; ++i) { const int sk = (i & 3) + 8 * (i >> 2) + 4 * hh; pt[i] = (sk <= r) ? pt[i] + pt2[i] : 0.f; }
            if (BR == 1) {
#pragma unroll
                for (int g4 = 0; g4 < 4; ++g4) { const f32x4 iv = *(const LAS f32x4*)(IV + 8 * g4 + 4 * hh); den += pt[4 * g4] * iv.x + pt[4 * g4 + 1] * iv.y + pt[4 * g4 + 2] * iv.z + pt[4 * g4 + 3] * iv.w; }
#pragma unroll 2
                for (int k = 0; k < 8; ++k) { const u32x4 qw = *(const LAS u32x4*)(lds + MS_QT + r * MS_ROW + (64 * hh + 8 * k) * 2);
                    const f32x4 n0 = *(const LAS f32x4*)(NV + nvc + 64 * hh + 8 * k), n1 = *(const LAS f32x4*)(NV + nvc + 64 * hh + 8 * k + 4);
                    den += bflo(qw.x) * n0.x + bfhi(qw.x) * n0.y + bflo(qw.y) * n0.z + bfhi(qw.y) * n0.w + bflo(qw.z) * n1.x + bfhi(qw.z) * n1.y + bflo(qw.w) * n1.z + bfhi(qw.w) * n1.w; }
                den += __shfl_xor(den, 32);
            }
#pragma unroll
            for (int ks = 0; ks < 2; ++ks) { const bf16x8 vf = ld2x64(lds + MS_VT + (32 * wv + r) * MS_TROW + (16 * ks + 4 * hh) * 2); ot = MFMA32(vf, pack8(pt, ks), ot); }
        }
#pragma unroll
        for (int i = 0; i < 16; ++i) ot[i] += ot2[i];
#pragma unroll
        for (int dj = 0; dj < 2; ++dj) { const int db = 2 * dh + dj;
#pragma unroll
            for (int ks = 0; ks < 2; ++ks) { const bf16x8 af = *(const LAS bf16x8*)(lds + MS_BTT + (32 * db + r) * MS_TROW + (16 * ks + 8 * hh) * 2), vf = *(const LAS bf16x8*)(lds + MS_VT + (32 * wv + r) * MS_TROW + (16 * ks + 8 * hh) * 2);
                S[dj] = MFMA32(af, vf, S[dj]); }
#pragma unroll
            for (int g4 = 0; g4 < 4; ++g4) { const f32x4 al = *(const LAS f32x4*)(AL + 32 * db + 8 * g4 + 4 * hh);
                S[dj][4 * g4] *= al.x; S[dj][4 * g4 + 1] *= al.y; S[dj][4 * g4 + 2] *= al.z; S[dj][4 * g4 + 3] *= al.w; }
        }
        __builtin_amdgcn_s_setprio(0);
        if (BR == 1 && wave >= 6) {
            const int d = 64 * (wave - 6) + lane; float ns = 0.f;
#pragma unroll 2
            for (int k = 0; k < 4; ++k) { const u32x4 bw = *(const LAS u32x4*)(lds + MS_BTT + d * MS_TROW + 16 * k); const f32x4 i0 = *(const LAS f32x4*)(IV + 8 * k), i1 = *(const LAS f32x4*)(IV + 8 * k + 4);
                ns += bflo(bw.x) * i0.x + bfhi(bw.x) * i0.y + bflo(bw.y) * i0.z + bfhi(bw.y) * i0.w + bflo(bw.z) * i1.x + bfhi(bw.z) * i1.y + bflo(bw.w) * i1.z + bfhi(bw.w) * i1.w; }
            NV[nvn + d] = AL[d] * (NV[nvc + d] + ns);
        }
        if (dh == 1) {
#pragma unroll
            for (int g4 = 0; g4 < 4; ++g4) *(LAS f32x4*)(XO + ((wv * 4 + g4) * 64 + lane) * 4) = (f32x4){ot[4 * g4], ot[4 * g4 + 1], ot[4 * g4 + 2], ot[4 * g4 + 3]};
        }
        __builtin_amdgcn_sched_barrier(0);
#if SCAN_XBAR
        __syncthreads();
#endif
        part1(SETN);
        if (SCAN_DUP & 1) part1(SETN);
        __syncthreads();
        for (int orep = 0; orep < ((SCAN_DUP & 8) ? 2 : 1); ++orep)
        if (dh == 0) {
            const int t = ch * ML + r; const size_t mrow = (size_t)(b * TT + tok_of(t));
            const float sc = (BR == 1) ? 1.f / fmaxf(fabsf(den), 1.f) : 1.f;
            bf16_t* op = Ob + mrow * 1024 + 32 * wv + 4 * hh;
#pragma unroll
            for (int gp2 = 0; gp2 < 4; gp2 += 2) {
            f32x4 pov[2];
#pragma unroll
            for (int g4 = 0; g4 < 2; ++g4) pov[g4] = *(const LAS f32x4*)(XO + ((wv * 4 + gp2 + g4) * 64 + lane) * 4);
#pragma unroll
            for (int g4i = 0; g4i < 2; ++g4i) { const int g4 = gp2 + g4i; const f32x4 po = pov[g4i];
                u32x2 w;
                if (BR == 1) { w.x = pk2((ot[4 * g4] + po.x) * sc, (ot[4 * g4 + 1] + po.y) * sc); w.y = pk2((ot[4 * g4 + 2] + po.z) * sc, (ot[4 * g4 + 3] + po.w) * sc); }
                else { w.x = pk2(ot[4 * g4] + po.x, ot[4 * g4 + 1] + po.y); w.y = pk2(ot[4 * g4 + 2] + po.z, ot[4 * g4 + 3] + po.w); }
                st_b64_untracked(op + 8 * g4, w); }
            }
        }
#if SCAN_XBAR
        __syncthreads();
#endif
        part2(SETN);
        if (SCAN_DUP & 2) part2(SETN);
        __builtin_amdgcn_sched_barrier(0);
        issue(ch + 3, SETN);
        if (SCAN_DUP & 16) { asm volatile("" ::: "memory"); issue(ch + 3, SETN); }
        __syncthreads();
    };
    for (int ch = 0; ch < MNCH; ch += 2) { iter(ch, IC1); iter(ch + 1, IC0); }
}

constexpr int KS_ROWB = 272, VT_ROWB = 72, KS_BYTES = 32 * KS_ROWB, VT_BYTES = 128 * VT_ROWB, AT_BUF = KS_BYTES + VT_BYTES;
template <bool LAT>
__device__ __forceinline__ void attn_unit(const Params& p, int layer, int b, int qg, int kvh, LAS unsigned char* lds) {
    const int tid = opaque_tid(), lane = tid & 63, wave = __builtin_amdgcn_readfirstlane(tid >> 6), r = lane & 31, hh = lane >> 5;
    const bf16_t* P = (const bf16_t*)(p.ws + WS_P);
    bf16_t* Y = (bf16_t*)(p.ws + WS_A);
    const float* tab = (const float*)(p.ws + WS_ROPE);
    const int head = kvh * 4 + (wave >> 1), qpos = qg * 64 + (wave & 1) * 32 + r;
    const int mq = b * TT + (LAT ? CTXL + qpos : qpos);
    bf16x8 qf[8];
    {
        const bf16_t* qp = P + (size_t)mq * NP + C_CQ + head * 128 + 8 * hh;
        const float scl = 0.08838834764831845f;
#pragma unroll
        for (int g = 0; g < 4; ++g) {
            const int s0 = (g & 1) + 4 * (g >> 1);
            const u32x4 ra = *(const u32x4*)(qp + 16 * s0), rb = *(const u32x4*)(qp + 16 * (s0 + 2));
            float xa[8] = {bflo(ra.x), bfhi(ra.x), bflo(ra.y), bfhi(ra.y), bflo(ra.z), bfhi(ra.z), bflo(ra.w), bfhi(ra.w)};
            float xb[8] = {bflo(rb.x), bfhi(rb.x), bflo(rb.y), bfhi(rb.y), bflo(rb.z), bfhi(rb.z), bflo(rb.w), bfhi(rb.w)};
            float oa[8], ob[8];
            if (LAT) {
                const int pos = (g < 2) ? (qpos >> 6) : (qpos & 63); const int i0 = 16 * (g & 1) + 8 * hh;
                const f32x4* tp = (const f32x4*)(tab + (size_t)(pos * 32 + i0) * 2);
#pragma unroll
                for (int jj = 0; jj < 4; ++jj) { const f32x4 cs = tp[jj];
                    oa[2 * jj] = xa[2 * jj] * cs.x - xb[2 * jj] * cs.y; ob[2 * jj] = xb[2 * jj] * cs.x + xa[2 * jj] * cs.y;
                    oa[2 * jj + 1] = xa[2 * jj + 1] * cs.z - xb[2 * jj + 1] * cs.w; ob[2 * jj + 1] = xb[2 * jj + 1] * cs.z + xa[2 * jj + 1] * cs.w; }
            } else {
#pragma unroll
                for (int j = 0; j < 8; ++j) { oa[j] = xa[j]; ob[j] = xb[j]; }
            }
            u32x4 wa, wb;
            wa.x = pk2(oa[0] * scl, oa[1] * scl); wa.y = pk2(oa[2] * scl, oa[3] * scl); wa.z = pk2(oa[4] * scl, oa[5] * scl); wa.w = pk2(oa[6] * scl, oa[7] * scl);
            wb.x = pk2(ob[0] * scl, ob[1] * scl); wb.y = pk2(ob[2] * scl, ob[3] * scl); wb.z = pk2(ob[4] * scl, ob[5] * scl); wb.w = pk2(ob[6] * scl, ob[7] * scl);
            qf[s0] = __builtin_bit_cast(bf16x8, wa); qf[s0 + 2] = __builtin_bit_cast(bf16x8, wb);
        }
    }
    const int skey = tid >> 4, sc = tid & 15;
    constexpr int NLAT = LAT ? 10 : 0, NT = NLAT + 8;
    u32x4 kraw, kprt, vraw; int kpos = 0; bool krope = false;
    auto issue = [&](int j) {
        int row;
        if (j < NLAT) { const int s = qg * 64 - 128 + 32 * j + skey; const int scl = s < 0 ? 0 : (s > SEQ - 1 ? SEQ - 1 : s); row = b * TT + CTXL + scl; kpos = scl; krope = true; }
        else { row = b * TT + 32 * (j - NLAT) + skey; krope = false; }
        const bf16_t* pr = P + (size_t)row * NP;
        kraw = *(const u32x4*)(pr + C_CK + kvh * 128 + 8 * sc);
        kprt = *(const u32x4*)(pr + C_CK + kvh * 128 + 8 * (sc ^ 4));
        vraw = *(const u32x4*)(pr + C_CV + kvh * 128 + 8 * sc);
    };
    auto stage = [&](int buf) {
        LAS unsigned char* ks = lds + buf * AT_BUF; LAS unsigned char* vt = ks + KS_BYTES;
        u32x4 kw = kraw;
        if (LAT && krope) {
            const float x[8] = {bflo(kraw.x), bfhi(kraw.x), bflo(kraw.y), bfhi(kraw.y), bflo(kraw.z), bfhi(kraw.z), bflo(kraw.w), bfhi(kraw.w)};
            const float y[8] = {bflo(kprt.x), bfhi(kprt.x), bflo(kprt.y), bfhi(kprt.y), bflo(kprt.z), bfhi(kprt.z), bflo(kprt.w), bfhi(kprt.w)};
            const int pos = (sc < 8) ? (kpos >> 6) : (kpos & 63); const int i0 = (8 * sc) & 31; const float sg = (sc & 4) ? 1.f : -1.f;
            const f32x4* tp = (const f32x4*)(tab + (size_t)(pos * 32 + i0) * 2);
            float o[8];
#pragma unroll
            for (int jj = 0; jj < 4; ++jj) { const f32x4 cs = tp[jj]; o[2 * jj] = x[2 * jj] * cs.x + sg * y[2 * jj] * cs.y; o[2 * jj + 1] = x[2 * jj + 1] * cs.z + sg * y[2 * jj + 1] * cs.w; }
            kw.x = pk2(o[0], o[1]); kw.y = pk2(o[2], o[3]); kw.z = pk2(o[4], o[5]); kw.w = pk2(o[6], o[7]);
        }
        *(LAS u32x4*)(ks + skey * KS_ROWB + sc * 16) = kw;
        LAS unsigned short* vp = (LAS unsigned short*)(vt + (8 * sc) * VT_ROWB + skey * 2);
        vp[0 * (VT_ROWB / 2)] = (unsigned short)(vraw.x & 0xffffu); vp[1 * (VT_ROWB / 2)] = (unsigned short)(vraw.x >> 16);
        vp[2 * (VT_ROWB / 2)] = (unsigned short)(vraw.y & 0xffffu); vp[3 * (VT_ROWB / 2)] = (unsigned short)(vraw.y >> 16);
        vp[4 * (VT_ROWB / 2)] = (unsigned short)(vraw.z & 0xffffu); vp[5 * (VT_ROWB / 2)] = (unsigned short)(vraw.z >> 16);
        vp[6 * (VT_ROWB / 2)] = (unsigned short)(vraw.w & 0xffffu); vp[7 * (VT_ROWB / 2)] = (unsigned short)(vraw.w >> 16);
    };
    f32x16 O[4];
#pragma unroll
    for (int k = 0; k < 4; ++k)
#pragma unroll
        for (int i = 0; i < 16; ++i) O[k][i] = 0.f;
    float mrun = p.in[12][layer * 8 + head], lrun = 1.f;
    __syncthreads();
    issue(0); stage(0);
    __syncthreads();
    for (int j = 0; j < NT; ++j) {
        const int buf = j & 1;
        if (j + 1 < NT) issue(j + 1);
        const LAS unsigned char* ks = lds + buf * AT_BUF; const LAS unsigned char* vt = ks + KS_BYTES;
        const int s0t = qg * 64 - 128 + 32 * j, rel = -128 + 32 * j - 32 * (wave & 1);
        const bool islat = LAT && j < NLAT;
        const bool skipt = islat && (rel <= -160 || rel >= 160 || s0t + 31 < 0 || s0t >= SEQ);
        const bool needmask = islat && !(rel >= -96 && rel <= 96 && s0t >= 0 && s0t + 31 < SEQ);
        if (!skipt) {
        f32x16 sa;
#pragma unroll
        for (int i = 0; i < 16; ++i) sa[i] = 0.f;
#pragma unroll
        for (int s = 0; s < 8; ++s) { const bf16x8 kf = *(const LAS bf16x8*)(ks + r * KS_ROWB + (16 * s + 8 * hh) * 2); sa = MFMA32(kf, qf[s], sa); }
        if (needmask) {
            const int s0 = qg * 64 - 128 + 32 * j + 4 * hh;
#pragma unroll
            for (int i = 0; i < 16; ++i) { const int sk = s0 + (i & 3) + 8 * (i >> 2); const int dd = qpos - sk; const bool ok = ((unsigned)sk < (unsigned)SEQ) && (dd <= 128) && (dd >= -128); sa[i] = ok ? sa[i] : -1e30f; }
        }
        float mx = sa[0];
#pragma unroll
        for (int i = 1; i < 16; ++i) mx = fmaxf(mx, sa[i]);
        mx = fmaxf(mx, __shfl_xor(mx, 32));
        const float mnew = fmaxf(mrun, mx), alpha = __expf(mrun - mnew);
        float ps = 0.f; float pv[16];
#pragma unroll
        for (int i = 0; i < 16; ++i) { pv[i] = __expf(sa[i] - mnew); ps += pv[i]; }
        ps += __shfl_xor(ps, 32);
        lrun = lrun * alpha + ps; mrun = mnew;
#pragma unroll
        for (int k = 0; k < 4; ++k)
#pragma unroll
            for (int i = 0; i < 16; ++i) O[k][i] *= alpha;
#pragma unroll
        for (int s = 0; s < 2; ++s) {
            u32x4 pw; pw.x = pk2(pv[8 * s], pv[8 * s + 1]); pw.y = pk2(pv[8 * s + 2], pv[8 * s + 3]); pw.z = pk2(pv[8 * s + 4], pv[8 * s + 5]); pw.w = pk2(pv[8 * s + 6], pv[8 * s + 7]);
            const bf16x8 pf = __builtin_bit_cast(bf16x8, pw);
#pragma unroll
            for (int k = 0; k < 4; ++k) {
                const LAS unsigned char* vr = vt + (32 * k + r) * VT_ROWB + (16 * s + 4 * hh) * 2;
                const u32x2 lo = *(const LAS u32x2*)(vr), hi = *(const LAS u32x2*)(vr + 16);
                u32x4 vw; vw.x = lo.x; vw.y = lo.y; vw.z = hi.x; vw.w = hi.y;
                O[k] = MFMA32(__builtin_bit_cast(bf16x8, vw), pf, O[k]);
            }
        }
        }
        if (j + 1 < NT) stage(buf ^ 1);
        __syncthreads();
    }
    const float inv = 1.f / lrun;
    const bf16_t* zp = P + (size_t)mq * NP + C_CZ + head * 128 + 4 * hh;
    bf16_t* yp = (bf16_t*)(p.ws + WS_P) + (size_t)mq * NP + C_CQ + head * 128 + 4 * hh;
    u32x2 zr[4][4];
#pragma unroll
    for (int k = 0; k < 4; ++k)
#pragma unroll
        for (int g = 0; g < 4; ++g) zr[k][g] = *(const u32x2*)(zp + 32 * k + 8 * g);
#pragma unroll
    for (int k = 0; k < 4; ++k)
#pragma unroll
        for (int g = 0; g < 4; ++g) {
            const u32x2 z = zr[k][g];
            const float o0 = O[k][4 * g] * inv * siluf(bflo(z.x)), o1 = O[k][4 * g + 1] * inv * siluf(bfhi(z.x)), o2 = O[k][4 * g + 2] * inv * siluf(bflo(z.y)), o3 = O[k][4 * g + 3] * inv * siluf(bfhi(z.y));
            u32x2 w; w.x = pk2(o0, o1); w.y = pk2(o2, o3);
            st_b64_untracked(yp + 32 * k + 8 * g, w);
        }
}

__device__ __forceinline__ void mixer_phase(const Params& p, int layer, LAS unsigned char* lds) {
    const int G = (int)gridDim.x, bid = (int)blockIdx.x;
    const int nunits = 512 + (layer == 0 ? 32 : 0);
#if USE_VALU_SCAN == 1
    for (int u = bid; u < 256; u += G) { if (u < 128) scan_unit<0>(p, layer, u, lds); else scan_unit<1>(p, layer, u, lds); }
    const int a0 = bid, astep = G;
#elif USE_VALU_SCAN == 2
    if (bid < 32) scan_mfma<0>(p, layer, bid, lds); else if (bid < 160) scan_unit<1>(p, layer, 128 + bid - 32, lds);
    const int a0 = bid, astep = G;
#elif USE_VALU_SCAN == 3
    if (bid < 32) scan_mfma<1>(p, layer, 32 + bid, lds); else if (bid < 160) scan_unit<0>(p, layer, bid - 32, lds);
    const int a0 = bid, astep = G;
#else
    const bool split = G > 2 * SCAN_WGS;
    for (int rep = 0; rep < ((MIX_DUP & 3) ? 2 : 1); ++rep)
    for (int u = bid; u < 64; u += (split ? 64 : G)) { if (u < 32) { if (MIX_MASK & 1) scan_mfma<0>(p, layer, u, lds); } else { if (MIX_MASK & 2) scan_mfma<1>(p, layer, u, lds); } }
    if (split && bid >= SCAN_WGS) {
        const int na = G - SCAN_WGS;
        pg8::Gemm g{(const bf16_t*)(p.ws + WS_A), (const bf16_t*)(p.ws + WS_WIN) + (size_t)layer * NP * D + (size_t)NX * D, MROWS, NY1, D};
        pg8::StaticOrder S; S.init(MROWS, NY1, na, bid - SCAN_WGS);
        pg8::EpiP E{(bf16_t*)(p.ws + WS_P) + NX, NP};
        pg8::gemm_phase<pg8::EpiP, pg8::StaticOrder, true, true>(lds, g, S, E);
        unsigned* cnt = (unsigned*)(p.ws + WS_BAR) + layer * 64;
        asm volatile("s_waitcnt vmcnt(0)" ::: "memory");
        __syncthreads();
        if (threadIdx.x == 0) {
            __builtin_amdgcn_fence(__ATOMIC_RELEASE, "agent");
            asm volatile("s_waitcnt vmcnt(0)" ::: "memory");
            __hip_atomic_fetch_add(cnt, 1u, __ATOMIC_RELAXED, __HIP_MEMORY_SCOPE_AGENT);
            unsigned spins = 0;
            while (__hip_atomic_load(cnt, __ATOMIC_RELAXED, __HIP_MEMORY_SCOPE_AGENT) < (unsigned)na) { __builtin_amdgcn_s_sleep(2); if (++spins > (1u << 24)) break; }
            __builtin_amdgcn_fence(__ATOMIC_ACQUIRE, "agent");
            asm volatile("s_waitcnt vmcnt(0)" ::: "memory");
        }
        __syncthreads();
    }
    const int a0 = split ? (bid < SCAN_WGS ? nunits : bid - SCAN_WGS) : bid, astep = split ? G - SCAN_WGS : G;
#endif
    for (int rep = 0; rep < ((MIX_DUP & 4) ? 2 : 1); ++rep)
    if (MIX_MASK & 4) for (int u = a0; u < nunits; u += astep) {
        if (u < 512) attn_unit<true>(p, layer, u >> 7, (u & 127) >> 1, u & 1, lds);
        else { const int v = u - 512; attn_unit<false>(p, layer, (v >> 3) & 3, (v >> 1) & 3, v & 1, lds); }
    }
#if USE_VALU_SCAN == 0
    if (layer == 0 && split && bid >= SCAN_WGS) { __syncthreads(); weight_transposes(p, lds, 1, (bid - SCAN_WGS) * 8 + ((int)threadIdx.x >> 6), (G - SCAN_WGS) * 8); }
#endif
}

__device__ __forceinline__ void readout_phase(const Params& p, int layer) {
    const int tid = opaque_tid(), lane = tid & 63, wave = tid >> 6;
    const int gw = blockIdx.x * 8 + wave, NGW = gridDim.x * 8;
    const bf16_t* P = (const bf16_t*)(p.ws + WS_P);
    const bf16_t* Of = (const bf16_t*)(p.ws + WS_O); const bf16_t* Obk = Of + (size_t)MROWS * 1024;
    bf16_t* Y = (bf16_t*)(p.ws + WS_A);
    const int ch0 = lane * 16; const bool isb = lane >= 32;
    for (int m0 = gw; m0 < MROWS; m0 += 2 * NGW) {
        int mm[2]; bool act[2];
        u32x4 fr[2][2], br[2][2], gr[2][2], orr[2][2], cr[2][2];
#pragma unroll
        for (int q = 0; q < 2; ++q) {
            const int mq_ = m0 + q * NGW; const int m = mq_ < MROWS ? mq_ : MROWS - 1; mm[q] = m;
            act[q] = (mq_ < MROWS) && !(layer == 1 && (m % TT) < CTXL);
            fr[q][0] = *(const u32x4*)(Of + (size_t)m * 1024 + ch0); fr[q][1] = *(const u32x4*)(Of + (size_t)m * 1024 + ch0 + 8);
            br[q][0] = *(const u32x4*)(Obk + (size_t)m * 1024 + ch0); br[q][1] = *(const u32x4*)(Obk + (size_t)m * 1024 + ch0 + 8);
            const bf16_t* gp = P + (size_t)m * NP + (isb ? C_BZ + ch0 - 512 : C_AG + ch0);
            gr[q][0] = *(const u32x4*)(gp); gr[q][1] = *(const u32x4*)(gp + 8);
            const bf16_t* op = P + (size_t)m * NP + C_BO + (isb ? ch0 - 512 : ch0);
            orr[q][0] = *(const u32x4*)(op); orr[q][1] = *(const u32x4*)(op + 8);
            const bf16_t* cp = P + (size_t)m * NP + C_CQ + ch0;
            cr[q][0] = *(const u32x4*)(cp); cr[q][1] = *(const u32x4*)(cp + 8);
        }
#pragma unroll
        for (int q = 0; q < 2; ++q) {
            if (!act[q]) continue;
            const int m = mm[q];
            float y[16], g[16];
            const unsigned fw[8] = {fr[q][0].x, fr[q][0].y, fr[q][0].z, fr[q][0].w, fr[q][1].x, fr[q][1].y, fr[q][1].z, fr[q][1].w};
            const unsigned bw[8] = {br[q][0].x, br[q][0].y, br[q][0].z, br[q][0].w, br[q][1].x, br[q][1].y, br[q][1].z, br[q][1].w};
            const unsigned gw8[8] = {gr[q][0].x, gr[q][0].y, gr[q][0].z, gr[q][0].w, gr[q][1].x, gr[q][1].y, gr[q][1].z, gr[q][1].w};
#pragma unroll
            for (int e = 0; e < 8; ++e) { y[2 * e] = bflo(fw[e]) + bflo(bw[e]); y[2 * e + 1] = bfhi(fw[e]) + bfhi(bw[e]); g[2 * e] = bflo(gw8[e]); g[2 * e + 1] = bfhi(gw8[e]); }
            if (isb) {
                const unsigned ow[8] = {orr[q][0].x, orr[q][0].y, orr[q][0].z, orr[q][0].w, orr[q][1].x, orr[q][1].y, orr[q][1].z, orr[q][1].w};
#pragma unroll
                for (int e = 0; e < 8; ++e) { y[2 * e] *= sigm(bflo(ow[e])); y[2 * e + 1] *= sigm(bfhi(ow[e])); }
            }
            float ss = 0.f;
#pragma unroll
            for (int e = 0; e < 16; ++e) ss += y[e] * y[e];
            ss += __shfl_xor(ss, 1); ss += __shfl_xor(ss, 2); ss += __shfl_xor(ss, 4);
            const float rs = __builtin_amdgcn_rsqf(ss * (1.f / 128.f) + EPS);
            u32x4 w0, w1; unsigned ww[8];
#pragma unroll
            for (int e = 0; e < 8; ++e) ww[e] = pk2(y[2 * e] * rs * siluf(g[2 * e]), y[2 * e + 1] * rs * siluf(g[2 * e + 1]));
            w0.x = ww[0]; w0.y = ww[1]; w0.z = ww[2]; w0.w = ww[3]; w1.x = ww[4]; w1.y = ww[5]; w1.z = ww[6]; w1.w = ww[7];
            *(u32x4*)(Y + (size_t)m * D + ch0) = w0; *(u32x4*)(Y + (size_t)m * D + ch0 + 8) = w1;
            *(u32x4*)(Y + (size_t)m * D + 1024 + ch0) = cr[q][0]; *(u32x4*)(Y + (size_t)m * D + 1024 + ch0 + 8) = cr[q][1];
        }
    }
}

#define XB_TMO      128
#define XB_XCNT(j)  (256  + 64 * (j))
#define XB_XSUB(j)  (1280 + 64 * (j))
#define XB_XGEN(j)  (2304 + 64 * (j))
#define XB_TOP      3328
#define XB_TOPGEN   3392
#define XCD_BAR_WORDS 3456
#define XB_SPIN_CAP (1u << 18)

__device__ __forceinline__ unsigned xb_ld(unsigned* p)              { return __hip_atomic_load(p, __ATOMIC_RELAXED, __HIP_MEMORY_SCOPE_AGENT); }
__device__ __forceinline__ unsigned xb_add(unsigned* p, unsigned v) { return __hip_atomic_fetch_add(p, v, __ATOMIC_RELAXED, __HIP_MEMORY_SCOPE_AGENT); }
__device__ __forceinline__ unsigned xb_xcc_id() { return (unsigned)__builtin_amdgcn_s_getreg((3 << 11) | 20) & 0xFu; }
#define XB_SPIN(cond, bar) do { unsigned _sp = 0; while (cond) { __builtin_amdgcn_s_sleep(1); \
    if ((++_sp & 255u) == 0u) { if (xb_ld(&(bar)[XB_TMO])) break; if (_sp > XB_SPIN_CAP) { atomicAdd(&(bar)[XB_TMO], 1u); break; } } } } while (0)

struct XcdBarrier {
    unsigned* bar; unsigned x;
    volatile LAS unsigned* st;
};

__device__ __forceinline__ XcdBarrier xcd_barrier_post(unsigned* bar, volatile LAS unsigned* st) {
    XcdBarrier b; b.bar = bar; b.x = xb_xcc_id(); b.st = st;
    if (threadIdx.x == 0) (void)xb_add(&bar[XB_XCNT(b.x)], 1u);
    return b;
}
__device__ __forceinline__ void xcd_barrier_complete(unsigned* bar, unsigned x, unsigned& nloc, unsigned& nx) {
    const unsigned G = gridDim.x * gridDim.y * gridDim.z;
    unsigned sum, cnt, mine, sp = 0u;
    for (;;) {
        sum = 0u; cnt = 0u; mine = 0u;
#pragma unroll
        for (unsigned j = 0; j < 16; ++j) { const unsigned c = xb_ld(&bar[XB_XCNT(j)]); sum += c; cnt += (c > 0u) ? 1u : 0u; mine = (j == x) ? c : mine; }
        if (sum == G) break;
        __builtin_amdgcn_s_sleep(1);
        if ((++sp & 255u) == 0u) { if (xb_ld(&bar[XB_TMO])) break; if (sp > XB_SPIN_CAP) { atomicAdd(&bar[XB_TMO], 1u); break; } }
    }
    nloc = mine > 0u ? mine : 1u; nx = cnt > 0u ? cnt : 1u;
}

__device__ __forceinline__ void xcd_barrier(const XcdBarrier& b) {
    asm volatile("s_waitcnt vmcnt(0)" ::: "memory");
    __syncthreads();
    if (threadIdx.x == 0) {
        unsigned* bar = b.bar;
        __builtin_amdgcn_s_waitcnt(0);
        unsigned nloc = b.st[0], nx = b.st[1];
        if (nloc == 0u) { xcd_barrier_complete(bar, b.x, nloc, nx); b.st[0] = nloc; b.st[1] = nx; }
        const unsigned old = xb_add(&bar[XB_XSUB(b.x)], 1u);
        const unsigned gen = old / nloc;
        if (old + 1u == (gen + 1u) * nloc) {
            __builtin_amdgcn_fence(__ATOMIC_RELEASE, "agent");
            asm volatile("s_waitcnt vmcnt(0)" ::: "memory");
            const unsigned og = xb_add(&bar[XB_TOP], 1u);
            const unsigned tg = og / nx;
            if (og + 1u == (tg + 1u) * nx) xb_add(&bar[XB_TOPGEN], 1u);
            else XB_SPIN(xb_ld(&bar[XB_TOPGEN]) == tg, bar);
            __builtin_amdgcn_fence(__ATOMIC_ACQUIRE, "agent");
            xb_add(&bar[XB_XGEN(b.x)], 1u);
            asm volatile("s_waitcnt vmcnt(0)" ::: "memory");
        } else {
            XB_SPIN(xb_ld(&bar[XB_XGEN(b.x)]) == gen, bar);
            __builtin_amdgcn_fence(__ATOMIC_ACQUIRE, "agent");
            asm volatile("s_waitcnt vmcnt(0)" ::: "memory");
        }
    }
    __syncthreads();
}

__global__ void __launch_bounds__(512, 2) mega_fwd(Params p) {
    extern __shared__ __attribute__((aligned(16))) unsigned char lds_raw[];
    LAS unsigned char* lds = (LAS unsigned char*)lds_raw;
    cg::grid_group grid = cg::this_grid();
    volatile LAS unsigned* xst = (volatile LAS unsigned*)(lds + 131072);
    if (threadIdx.x < 2) xst[threadIdx.x] = 0u;
    __syncthreads();
    XcdBarrier xbar = xcd_barrier_post((unsigned*)(p.ws + WS_XBAR), xst);
    for (int ph = p.ph_lo; ph < p.ph_hi; ++ph) {
        int nrep = 1;
        if (DUP_MASK != 0 && ph >= 2 && ((DUP_MASK >> ((ph - 2) % 5)) & 1)) nrep = 2;
        for (int rep = 0; rep < nrep; ++rep) {
        if (ph == 0) { if (PH_MASK & 1) p0_prologue(p, lds); }
        else if (ph == 1) { if (PH_MASK & 2) row_phase<0>(p); }
        else {
            const int layer = (ph - 2) / 5, sub = (ph - 2) % 5;
            if (sub == 0) { if (PH_MASK & 4) {
                const int nfirst = ((int)gridDim.x > 2 * SCAN_WGS) ? NX : NP;
                pg8::Gemm g{(const bf16_t*)(p.ws + WS_A), (const bf16_t*)(p.ws + WS_WIN) + (size_t)layer * NP * D, MROWS, nfirst, D};
                pg8::StaticOrder S; S.init(MROWS, nfirst, (int)gridDim.x, (int)blockIdx.x);
                pg8::EpiP E{(bf16_t*)(p.ws + WS_P), NP};
                pg8::gemm_phase<pg8::EpiP, pg8::StaticOrder, true, true>(lds, g, S, E); }
            } else if (sub == 1) { if (PH_MASK & 8) mixer_phase(p, layer, lds); }
            else if (sub == 2) { if (PH_MASK & 16) readout_phase(p, layer); }
            else if (sub == 3) { if (PH_MASK & 32) {
                pg8::Gemm g{(const bf16_t*)(p.ws + WS_A), (const bf16_t*)(p.ws + WS_WOUT) + (size_t)layer * D * D, MROWS, D, D};
                pg8::EpiP E{(bf16_t*)(p.ws + WS_P), D};
                if (layer == 0) { pg8::StaticOrder S; S.init(MROWS, D, (int)gridDim.x, (int)blockIdx.x); pg8::gemm_phase<pg8::EpiP, pg8::StaticOrder, true, true>(lds, g, S, E); }
                else { pg8::LatentOrder S; S.init(NBATCH * SEQ, D, (int)gridDim.x, (int)blockIdx.x); pg8::gemm_phase<pg8::EpiP, pg8::LatentOrder, true, true>(lds, g, S, E); } }
            } else { if (PH_MASK & 64) { if (layer == 0) row_phase<1>(p); else row_phase<2>(p); } }
        }
        }
        if (ph + 1 < p.ph_hi) { if (p.ph_hi > NPHASE) grid.sync(); else xcd_barrier(xbar); }
    }
}

#ifndef MK_PER_PHASE
#define MK_PER_PHASE 0
#endif
extern "C" void kernel_launch(void* const* d_in, const int* in_sizes, int n_in, void* d_out, int out_size, void* d_ws, size_t ws_size, hipStream_t stream) {
    static int grid = 0;
    if (grid == 0) {
        if (n_in != 14 || ws_size < WS_END) { fprintf(stderr, "kernel_launch: unexpected inputs (n_in %d, ws %zu < %zu)\n", n_in, ws_size, (size_t)WS_END); grid = -1; return; }
        int dev = 0, cus = 0, per_cu = 0;
        hipGetDevice(&dev); hipDeviceGetAttribute(&cus, hipDeviceAttributeMultiprocessorCount, dev);
        if (hipFuncSetAttribute((const void*)mega_fwd, hipFuncAttributeMaxDynamicSharedMemorySize, LDS_BYTES) != hipSuccess) { fprintf(stderr, "kernel_launch: hipFuncSetAttribute failed\n"); grid = -1; return; }
        if (hipOccupancyMaxActiveBlocksPerMultiprocessor(&per_cu, (const void*)mega_fwd, 512, LDS_BYTES) != hipSuccess || per_cu < 1) { fprintf(stderr, "kernel_launch: occupancy query says %d\n", per_cu); per_cu = 1; }
        (void)hipGetLastError();
        grid = cus * (per_cu > 1 ? 1 : per_cu);
        if (grid > 256) grid = 256;
    }
    if (grid < 0) return;
    (void)hipMemsetAsync((char*)d_ws + WS_MOD, 0, (size_t)2 * 5 * NMOD * 4 + 1024 + 16384, stream);
    Params p{};
    for (int i = 0; i < 14; ++i) p.in[i] = (const float*)d_in[i];
    p.out = (float*)d_out; p.ws = (unsigned char*)d_ws;
#if MK_PER_PHASE
    for (int ph = 0; ph < NPHASE; ++ph) { p.ph_lo = ph; p.ph_hi = ph + 1; hipLaunchKernelGGL(mega_fwd, dim3(grid), dim3(512), LDS_BYTES, stream, p); }
#else
    p.ph_lo = 0; p.ph_hi = NPHASE;
    void* args[] = {&p};
    hipError_t e = hipLaunchCooperativeKernel((const void*)mega_fwd, dim3(grid), dim3(512), args, LDS_BYTES, stream);
    if (e != hipSuccess) fprintf(stderr, "cooperative launch failed: %s (grid %d)\n", hipGetErrorString(e), grid);
#endif
}
```
